# Optimizing an MI355X kernel written in HIP

```python
import math
import jax, jax.numpy as jnp
from jax import lax
import numpy as np

D_MODEL = 1024
BATCH = 8
SEQ = 2048
DEPTH = 4
DEC_BATCH = 128
DEC_SEQ = 4
PAST_LEN = 16384
PAGE_SIZE = 128

N_MIXERS = 2
N_GDN = (DEPTH + 1) // 2
N_SSD = DEPTH // 2
CONV_W = 4
NORM_EPS = 1e-6
GDN_HEADS = 8
GDN_DK = 128
GDN_DV = 128
GDN_QK = GDN_HEADS * GDN_DK
GDN_VW = GDN_HEADS * GDN_DV
GDN_CONV_DIM = 2 * GDN_QK + GDN_VW
GDN_IN = GDN_CONV_DIM + GDN_VW + 2 * GDN_HEADS
GDN_CHUNK = 64
SSD_EXPAND = 2
SSD_DI = SSD_EXPAND * D_MODEL
SSD_HEADDIM = 64
SSD_HEADS = SSD_DI // SSD_HEADDIM
SSD_GROUPS = 4
SSD_DSTATE = 128
SSD_CONV_DIM = SSD_DI + 2 * SSD_GROUPS * SSD_DSTATE
SSD_IN = SSD_DI + SSD_CONV_DIM + SSD_HEADS
SSD_CHUNK = 64
D_FF = ((8 * D_MODEL + 3 * 256 - 1) // (3 * 256)) * 256

kernel_name = 'hybrid_gdn_ssd_decoder_step'

F32 = jnp.float32


def rms_norm(x, w, eps=NORM_EPS):
    xf = x.astype(F32)
    return xf * lax.rsqrt(jnp.mean(xf * xf, axis=-1, keepdims=True) + eps) * w.astype(F32)


def l2_normalize(x, eps=1e-6):
    return x * lax.rsqrt(jnp.sum(x * x, axis=-1, keepdims=True) + eps)


def causal_conv(x, buf, w, b=None):
    L = x.shape[1]
    xx = jnp.concatenate([buf, x], axis=1)
    out = sum(xx[:, j:j + L] * w[j] for j in range(CONV_W))
    if b is not None:
        out = out + b
    return out, xx[:, L:]


def gated_delta_chunked(q, k, v, g, beta, S0):
    Bsz, L, H, dk = q.shape
    dv = v.shape[-1]
    C = math.gcd(L, GDN_CHUNK)
    N = L // C

    def chunkify(t):
        return jnp.swapaxes(t.reshape((Bsz, N, C, H) + t.shape[3:]), 2, 3)

    q, k, v, g, beta = (chunkify(t) for t in (q, k, v, g, beta))
    G = jnp.cumsum(g, axis=-1)
    idx = jnp.arange(C)
    causal = idx[:, None] >= idx[None, :]
    strict = idx[:, None] > idx[None, :]
    seg = G[..., :, None] - G[..., None, :]
    decay = jnp.where(causal, jnp.exp(jnp.where(causal, seg, 0.0)), 0.0)
    kb = k * beta[..., None]
    M = jnp.where(strict, jnp.einsum('bnhik,bnhjk->bnhij', kb, k) * decay, 0.0)
    A = M + jnp.eye(C, dtype=M.dtype)
    rhs = jnp.concatenate([v * beta[..., None], kb * jnp.exp(G)[..., None]], axis=-1)
    sol = lax.linalg.triangular_solve(A, rhs, left_side=True, lower=True)
    u, w = sol[..., :dv], sol[..., dv:]
    attn = jnp.where(causal, jnp.einsum('bnhik,bnhjk->bnhij', q, k) * decay, 0.0)

    def step(S, inp):
        q_c, k_c, u_c, w_c, attn_c, G_c = inp
        v_new = u_c - jnp.einsum('bhck,bhkv->bhcv', w_c, S)
        o = (jnp.einsum('bhck,bhkv->bhcv', q_c * jnp.exp(G_c)[..., None], S)
             + jnp.einsum('bhij,bhjv->bhiv', attn_c, v_new))
        last = G_c[..., -1]
        S = (S * jnp.exp(last)[..., None, None]
             + jnp.einsum('bhck,bhcv->bhkv', k_c * jnp.exp(last[..., None] - G_c)[..., None], v_new))
        return S, o

    xs = tuple(jnp.moveaxis(t, 1, 0) for t in (q, k, u, w, attn, G))
    S, o = lax.scan(step, S0, xs)
    o = jnp.transpose(o, (1, 0, 3, 2, 4)).reshape(Bsz, L, H, dv)
    return o, S


def ssd_chunked(x, dt, A, Bm, Cm, h0):
    Bsz, L, H, P = x.shape
    G, S = Bm.shape[2], Bm.shape[3]
    Hg = H // G
    C = math.gcd(L, SSD_CHUNK)
    N = L // C
    xdt = (x * dt[..., None]).reshape(Bsz, N, C, G, Hg, P)
    Bc = Bm.reshape(Bsz, N, C, G, S)
    Cc = Cm.reshape(Bsz, N, C, G, S)
    a = jnp.moveaxis((dt * A).reshape(Bsz, N, C, G, Hg), 2, -1)
    Acum = jnp.cumsum(a, axis=-1)
    idx = jnp.arange(C)
    causal = idx[:, None] >= idx[None, :]
    seg = Acum[..., :, None] - Acum[..., None, :]
    decay = jnp.where(causal, jnp.exp(jnp.where(causal, seg, 0.0)), 0.0)
    CB = jnp.einsum('bnigs,bnjgs->bngij', Cc, Bc)
    y_diag = jnp.einsum('bnghij,bnjghp->bnighp', CB[:, :, :, None] * decay, xdt)

    def step(hprev, inp):
        xdt_c, B_c, C_c, A_c = inp
        y_off = (jnp.einsum('bigs,bghps->bighp', C_c, hprev)
                 * jnp.moveaxis(jnp.exp(A_c), -1, 1)[..., None])
        last = A_c[..., -1]
        wts = jnp.exp(last[..., None] - A_c)
        hnew = (hprev * jnp.exp(last)[..., None, None]
                + jnp.einsum('bghj,bjgs,bjghp->bghps', wts, B_c, xdt_c))
        return hnew, y_off

    xs = tuple(jnp.moveaxis(t, 1, 0) for t in (xdt, Bc, Cc, Acum))
    hN, y_off = lax.scan(step, h0.reshape(Bsz, G, Hg, P, S), xs)
    y = y_diag + jnp.moveaxis(y_off, 0, 1)
    return y.reshape(Bsz, L, H, P), hN.reshape(Bsz, H, P, S)


def gdn_mixer(h, S0, conv0, w_in, conv_w, A_log, dt_bias, norm_w, w_out):
    Bsz, L, _ = h.shape
    proj = (h @ w_in).astype(F32)
    qkv, z, b, a = jnp.split(proj, [GDN_CONV_DIM, GDN_CONV_DIM + GDN_VW,
                                    GDN_CONV_DIM + GDN_VW + GDN_HEADS], axis=-1)
    qkv, conv_new = causal_conv(qkv, conv0.astype(F32), conv_w.astype(F32))
    qkv = jax.nn.silu(qkv)
    q, k, v = jnp.split(qkv, [GDN_QK, 2 * GDN_QK], axis=-1)
    q = l2_normalize(q.reshape(Bsz, L, GDN_HEADS, GDN_DK)) * (GDN_DK ** -0.5)
    k = l2_normalize(k.reshape(Bsz, L, GDN_HEADS, GDN_DK))
    v = v.reshape(Bsz, L, GDN_HEADS, GDN_DV)
    beta = jax.nn.sigmoid(b)
    g = -jnp.exp(A_log.astype(F32)) * jax.nn.softplus(a + dt_bias.astype(F32))
    o, S = gated_delta_chunked(q, k, v, g, beta, S0.astype(F32))
    o = rms_norm(o, norm_w) * jax.nn.silu(z.reshape(Bsz, L, GDN_HEADS, GDN_DV))
    out = o.reshape(Bsz, L, GDN_VW) @ w_out
    return out, S, conv_new


def ssd_mixer(h, h0, conv0, w_in, conv_w, conv_b, dt_bias, A_log, D_skip, norm_w, w_out):
    Bsz, L, _ = h.shape
    proj = (h @ w_in).astype(F32)
    z, xBC, dt = jnp.split(proj, [SSD_DI, SSD_DI + SSD_CONV_DIM], axis=-1)
    xBC, conv_new = causal_conv(xBC, conv0.astype(F32), conv_w.astype(F32), conv_b.astype(F32))
    xBC = jax.nn.silu(xBC)
    xs, Bm, Cm = jnp.split(xBC, [SSD_DI, SSD_DI + SSD_GROUPS * SSD_DSTATE], axis=-1)
    xs = xs.reshape(Bsz, L, SSD_HEADS, SSD_HEADDIM)
    Bm = Bm.reshape(Bsz, L, SSD_GROUPS, SSD_DSTATE)
    Cm = Cm.reshape(Bsz, L, SSD_GROUPS, SSD_DSTATE)
    dt = jax.nn.softplus(dt + dt_bias.astype(F32))
    A = -jnp.exp(A_log.astype(F32))
    y, hN = ssd_chunked(xs, dt, A, Bm, Cm, h0.astype(F32))
    y = (y + D_skip.astype(F32)[:, None] * xs).reshape(Bsz, L, SSD_DI)
    y = rms_norm(y * jax.nn.silu(z), norm_w)
    return y @ w_out, hN, conv_new


def run_trunk(x, gdn_S, gdn_conv, ssd_h, ssd_conv, params):
    (mix_pre_norm, mix_post_norm, ffn_pre_norm, ffn_post_norm,
     gdn_w_in, gdn_conv_w, gdn_A_log, gdn_dt_bias, gdn_norm_w, gdn_w_out,
     ssd_w_in, ssd_conv_w, ssd_conv_b, ssd_dt_bias, ssd_A_log, ssd_D, ssd_norm_w, ssd_w_out,
     ffn_w_gate, ffn_w_up, ffn_w_down) = params
    new_gS, new_gC, new_sH, new_sC = [], [], [], []
    for i in range(DEPTH):
        j = i // N_MIXERS
        hn = rms_norm(x, mix_pre_norm[i])
        if i % N_MIXERS == 0:
            out, S, cbuf = gdn_mixer(hn, gdn_S[j], gdn_conv[j], gdn_w_in[j], gdn_conv_w[j],
                                     gdn_A_log[j], gdn_dt_bias[j], gdn_norm_w[j], gdn_w_out[j])
            new_gS.append(S.astype(gdn_S.dtype))
            new_gC.append(cbuf.astype(gdn_conv.dtype))
        else:
            out, hs, cbuf = ssd_mixer(hn, ssd_h[j], ssd_conv[j], ssd_w_in[j], ssd_conv_w[j],
                                      ssd_conv_b[j], ssd_dt_bias[j], ssd_A_log[j], ssd_D[j],
                                      ssd_norm_w[j], ssd_w_out[j])
            new_sH.append(hs.astype(ssd_h.dtype))
            new_sC.append(cbuf.astype(ssd_conv.dtype))
        x = x + rms_norm(out, mix_post_norm[i]).astype(x.dtype)
        hn = rms_norm(x, ffn_pre_norm[i])
        f = (jax.nn.silu(hn @ ffn_w_gate[i]) * (hn @ ffn_w_up[i])) @ ffn_w_down[i]
        x = x + rms_norm(f, ffn_post_norm[i]).astype(x.dtype)
    return x, jnp.stack(new_gS), jnp.stack(new_gC), jnp.stack(new_sH), jnp.stack(new_sC)


def setup_inputs(seed: int = 0) -> dict:
    key = jax.random.key(seed)
    ks = iter(jax.random.split(key, 40))

    def nrm(shape, scale):
        return jax.random.normal(next(ks), shape, F32) * scale

    def dt_bias_init(shape):
        dt = jnp.exp(jax.random.uniform(next(ks), shape, F32, math.log(1e-3), math.log(0.1)))
        return dt + jnp.log(-jnp.expm1(-dt))

    def a_log_init(shape):
        return jnp.log(jax.random.uniform(next(ks), shape, F32, 1.0, 16.0))

    def gain(shape):
        return 1.0 + nrm(shape, 0.02)

    return {
        'x_prompt': nrm((BATCH, SEQ, D_MODEL), 1.0),
        'x_sample': nrm((DEC_BATCH, DEC_SEQ, D_MODEL), 1.0),
        'state_gdn_S': nrm((N_GDN, DEC_BATCH, GDN_HEADS, GDN_DK, GDN_DV), 0.05),
        'state_gdn_conv': nrm((N_GDN, DEC_BATCH, CONV_W - 1, GDN_CONV_DIM), 1.0),
        'state_ssd_h': nrm((N_SSD, DEC_BATCH, SSD_HEADS, SSD_HEADDIM, SSD_DSTATE), 0.1),
        'state_ssd_conv': nrm((N_SSD, DEC_BATCH, CONV_W - 1, SSD_CONV_DIM), 1.0),
        'mix_pre_norm': gain((DEPTH, D_MODEL)),
        'mix_post_norm': gain((DEPTH, D_MODEL)),
        'ffn_pre_norm': gain((DEPTH, D_MODEL)),
        'ffn_post_norm': gain((DEPTH, D_MODEL)),
        'gdn_w_in': nrm((N_GDN, D_MODEL, GDN_IN), D_MODEL ** -0.5),
        'gdn_conv_w': nrm((N_GDN, CONV_W, GDN_CONV_DIM), CONV_W ** -0.5),
        'gdn_A_log': a_log_init((N_GDN, GDN_HEADS)),
        'gdn_dt_bias': dt_bias_init((N_GDN, GDN_HEADS)),
        'gdn_norm_w': gain((N_GDN, GDN_DV)),
        'gdn_w_out': nrm((N_GDN, GDN_VW, D_MODEL), GDN_VW ** -0.5),
        'ssd_w_in': nrm((N_SSD, D_MODEL, SSD_IN), D_MODEL ** -0.5),
        'ssd_conv_w': nrm((N_SSD, CONV_W, SSD_CONV_DIM), CONV_W ** -0.5),
        'ssd_conv_b': nrm((N_SSD, SSD_CONV_DIM), 0.02),
        'ssd_dt_bias': dt_bias_init((N_SSD, SSD_HEADS)),
        'ssd_A_log': a_log_init((N_SSD, SSD_HEADS)),
        'ssd_D': 1.0 + nrm((N_SSD, SSD_HEADS), 0.1),
        'ssd_norm_w': gain((N_SSD, SSD_DI)),
        'ssd_w_out': nrm((N_SSD, SSD_DI, D_MODEL), SSD_DI ** -0.5),
        'ffn_w_gate': nrm((DEPTH, D_MODEL, D_FF), D_MODEL ** -0.5),
        'ffn_w_up': nrm((DEPTH, D_MODEL, D_FF), D_MODEL ** -0.5),
        'ffn_w_down': nrm((DEPTH, D_FF, D_MODEL), D_FF ** -0.5),
    }


def reference(x_prompt, x_sample, state_gdn_S, state_gdn_conv, state_ssd_h, state_ssd_conv,
              mix_pre_norm, mix_post_norm, ffn_pre_norm, ffn_post_norm,
              gdn_w_in, gdn_conv_w, gdn_A_log, gdn_dt_bias, gdn_norm_w, gdn_w_out,
              ssd_w_in, ssd_conv_w, ssd_conv_b, ssd_dt_bias, ssd_A_log, ssd_D, ssd_norm_w, ssd_w_out,
              ffn_w_gate, ffn_w_up, ffn_w_down):
    params = (mix_pre_norm, mix_post_norm, ffn_pre_norm, ffn_post_norm,
              gdn_w_in, gdn_conv_w, gdn_A_log, gdn_dt_bias, gdn_norm_w, gdn_w_out,
              ssd_w_in, ssd_conv_w, ssd_conv_b, ssd_dt_bias, ssd_A_log, ssd_D, ssd_norm_w, ssd_w_out,
              ffn_w_gate, ffn_w_up, ffn_w_down)
    nb = x_prompt.shape[0]
    z_gS = jnp.zeros((N_GDN, nb) + state_gdn_S.shape[2:], state_gdn_S.dtype)
    z_gC = jnp.zeros((N_GDN, nb) + state_gdn_conv.shape[2:], state_gdn_conv.dtype)
    z_sH = jnp.zeros((N_SSD, nb) + state_ssd_h.shape[2:], state_ssd_h.dtype)
    z_sC = jnp.zeros((N_SSD, nb) + state_ssd_conv.shape[2:], state_ssd_conv.dtype)
    y_prompt, p_gS, p_gC, p_sH, p_sC = run_trunk(x_prompt, z_gS, z_gC, z_sH, z_sC, params)
    y_sample, s_gS, s_gC, s_sH, s_sC = run_trunk(x_sample, state_gdn_S, state_gdn_conv,
                                                 state_ssd_h, state_ssd_conv, params)
    return (y_prompt, y_sample, p_gS, p_gC, p_sH, p_sC, s_gS, s_gC, s_sH, s_sC)
```

```cpp
#include <hip/hip_runtime.h>
#include <hip/hip_cooperative_groups.h>
#include <cstdio>
#include <cstdint>
namespace cg = cooperative_groups;
namespace pg8 {
#define PG8_LAS __attribute__((address_space(3)))
typedef unsigned short bf16_t;
typedef short bf16x8 __attribute__((ext_vector_type(8)));
typedef float f32x4 __attribute__((ext_vector_type(4)));
typedef unsigned u32x4 __attribute__((ext_vector_type(4)));
constexpr int BM = 256, BK = 64, HALF = 128, HTB = HALF * BK * 2  , STAGE_BYTES = 8 * HTB, NXCD = 8, WGM = 8;

__host__ __device__ __forceinline__ int lds_byte(int r, int c) { const int st = (r >> 4) * 2 + (c >> 5), rr = r & 15, cc = c & 31, ob = rr * 64 + cc * 2; return st * 1024 + (ob ^ (((ob >> 9) & 1) << 5)); }
__host__ __device__ __forceinline__ void stage_rc(int b, int& R, int& C) { const int st = b / 1024, sb = b % 1024, swz = sb ^ (((sb >> 9) & 1) << 5); R = (st >> 1) * 16 + swz / 64; C = (st & 1) * 32 + (swz % 64) / 2; }
__host__ __device__ __forceinline__ int perm32(int rho) { const int n = rho >> 4, i = rho & 15; return 8 * (i >> 2) + 4 * n + (i & 3); }

struct Unit { int pm, pn; };
struct Gemm { const bf16_t* A; const bf16_t* Bt; int M, N, K, ld; };

struct StaticOrder {
    int nM, nN, nwg, G, c;
    __host__ __device__ void init(int M, int N, int G_, int c_) { nM = M / BM; nN = N / BM; nwg = nM * nN; G = G_; c = c_; }
    __host__ __device__ bool next(int i, Unit& u) const {
        const long L = (long)i * G + c; if (L >= nwg) return false;
        int wgid = (int)L; { const int q = nwg / NXCD, r = nwg % NXCD, xcd = wgid % NXCD, off = wgid / NXCD; wgid = (xcd < r ? xcd * (q + 1) : r * (q + 1) + (xcd - r) * q) + off; }
        const int nig = WGM * nN, gid = wgid / nig, fm = gid * WGM, gsz = (nM - fm) < WGM ? (nM - fm) : WGM;
        u.pm = fm + ((wgid % nig) % gsz); u.pn = (wgid % nig) / gsz; return true;
    }
    __device__ __forceinline__ void a_ready(const Unit&) const {}
    __device__ __forceinline__ void done(const Unit&) const {}
};

__device__ __forceinline__ unsigned cvt_pk_bf16(float lo, float hi) { unsigned r; asm volatile("v_cvt_pk_bf16_f32 %0, %1, %2" : "=v"(r) : "v"(lo), "v"(hi)); return r; }
__device__ __forceinline__ float silu_f(float x) { return x * __builtin_amdgcn_rcpf(1.0f + __expf(-x)); }
struct EpiBf16 {
    static constexpr bool PERM = true, AFTER_DRAIN = false;
    bf16_t* O; int ldc; bool wt;
    __device__ __forceinline__ void operator()(const f32x4 (&acc)[2][2][4][2], const Unit& u, int wr, int wc, int fr, int fq) const {
        const int row0 = u.pm * BM + wr * 64 + fr; const int col0 = u.pn * BM + wc * 32 + 8 * fq;
#pragma unroll
        for (int ai = 0; ai < 2; ++ai)
#pragma unroll
            for (int m = 0; m < 4; ++m) { bf16_t* rowp = O + (size_t)(row0 + ai * HALF + m * 16) * ldc + col0;
#pragma unroll
                for (int bj = 0; bj < 2; ++bj) { const f32x4 v0 = acc[ai][bj][m][0], v1 = acc[ai][bj][m][1];
                    u32x4 w; w.x = cvt_pk_bf16(v0[0], v0[1]); w.y = cvt_pk_bf16(v0[2], v0[3]); w.z = cvt_pk_bf16(v1[0], v1[1]); w.w = cvt_pk_bf16(v1[2], v1[3]);
                    if (wt) asm volatile("global_store_dwordx4 %0, %1, off sc1\n\ts_nop 1" :: "v"(rowp + bj * HALF), "v"(w) : "memory");
                    else *(u32x4*)(rowp + bj * HALF) = w; } }
    }
};
struct EpiSwiGLU {
    static constexpr bool PERM = true, AFTER_DRAIN = false;
    bf16_t* O; int ldc;
    __device__ __forceinline__ void operator()(const f32x4 (&acc)[2][2][4][2], const Unit& u, int wr, int wc, int fr, int fq) const {
        const int row0 = u.pm * BM + wr * 64 + fr; const int col0 = u.pn * HALF + wc * 32 + 8 * fq;
#pragma unroll
        for (int ai = 0; ai < 2; ++ai)
#pragma unroll
            for (int m = 0; m < 4; ++m) { bf16_t* rowp = O + (size_t)(row0 + ai * HALF + m * 16) * ldc + col0;
                const f32x4 g0 = acc[ai][0][m][0], g1 = acc[ai][0][m][1], u0 = acc[ai][1][m][0], u1 = acc[ai][1][m][1];
                u32x4 w;
                w.x = cvt_pk_bf16(silu_f(g0[0]) * u0[0], silu_f(g0[1]) * u0[1]); w.y = cvt_pk_bf16(silu_f(g0[2]) * u0[2], silu_f(g0[3]) * u0[3]);
                w.z = cvt_pk_bf16(silu_f(g1[0]) * u1[0], silu_f(g1[1]) * u1[1]); w.w = cvt_pk_bf16(silu_f(g1[2]) * u1[2], silu_f(g1[3]) * u1[3]);
                *(u32x4*)rowp = w; }
    }
};
struct EpiF32 {
    static constexpr bool PERM = false, AFTER_DRAIN = false;
    float* O; int ldc;
    __device__ __forceinline__ void operator()(const f32x4 (&acc)[2][2][4][2], const Unit& u, int wr, int wc, int fr, int fq) const {
        const int row0 = u.pm * BM + wr * 64 + fr; const int col0 = u.pn * BM + wc * 32 + 4 * fq;
#pragma unroll
        for (int ai = 0; ai < 2; ++ai)
#pragma unroll
            for (int m = 0; m < 4; ++m) { float* rowp = O + (size_t)(row0 + ai * HALF + m * 16) * ldc + col0;
#pragma unroll
                for (int bj = 0; bj < 2; ++bj)
#pragma unroll
                    for (int n = 0; n < 2; ++n) *(f32x4*)(rowp + bj * HALF + n * 16) = acc[ai][bj][m][n]; }
    }
};
template <class Epi, class Sched, bool ALIGN_EPI = false, bool SP2 = false>
__device__ __forceinline__ void gemm_phase(PG8_LAS unsigned char* lds, const Gemm g, const Sched& S, const Epi& E) {
    int tid_l = threadIdx.x; asm volatile("" : "+v"(tid_l));
    const int tid = tid_l, wid = __builtin_amdgcn_readfirstlane(tid >> 6), lane = tid & 63, wr = wid >> 2, wc = wid & 3, fr = lane & 15, fq = lane >> 4;
    const int K = g.K, nt = K / BK, LD = g.ld;
    unsigned voffA[2], voffB[2];
#pragma unroll
    for (int i = 0; i < 2; ++i) { int R, C; stage_rc(tid * 16 + i * 8192, R, C); const int Rb = Epi::PERM ? ((R & ~31) + perm32(R & 31)) : R;
        voffA[i] = (unsigned)(R * LD + C) * 2u; voffB[i] = (unsigned)(Rb * LD + C) * 2u; }
    const size_t kstep = (size_t)(BK * 2);
    const size_t hstep = (size_t)HALF * LD * 2;
    const size_t tstep = 2 * hstep;
    const unsigned ldsw = (unsigned)wid * 1024u;
    const int aoff = lds_byte(wr * 64 + fr, fq * 8), boff = lds_byte(wc * 32 + fr, fq * 8);
#define PG8_SA(b, h) (((b) * 2 + (h)) * HTB)
#define PG8_SB(b, h) ((4 + (b) * 2 + (h)) * HTB)
#define PG8_STAGE(bufoff, gbase, voff) do { _Pragma("unroll") for (int _i = 0; _i < 2; ++_i) \
        __builtin_amdgcn_global_load_lds((const unsigned*)((const char*)(gbase) + (voff)[_i]), (PG8_LAS unsigned*)(lds + (bufoff) + ldsw + _i * 8192), 16, 0, 0); } while (0)
#define PG8_LDA(dst, b, h) do { _Pragma("unroll") for (int m = 0; m < 4; ++m) _Pragma("unroll") for (int k = 0; k < 2; ++k) dst[m][k] = *(const PG8_LAS bf16x8*)(lds + PG8_SA(b, h) + aoff + m * 2048 + k * 1024); } while (0)
#define PG8_LDB(dst, b, h) do { _Pragma("unroll") for (int n = 0; n < 2; ++n) _Pragma("unroll") for (int k = 0; k < 2; ++k) dst[n][k] = *(const PG8_LAS bf16x8*)(lds + PG8_SB(b, h) + boff + n * 2048 + k * 1024); } while (0)
#define PG8_MMA(ai, bj, At, Bt) do { __builtin_amdgcn_s_setprio(1); _Pragma("unroll") for (int m = 0; m < 4; ++m) _Pragma("unroll") for (int n = 0; n < 2; ++n) _Pragma("unroll") for (int k = 0; k < 2; ++k) \
        acc[ai][bj][m][n] = __builtin_amdgcn_mfma_f32_16x16x32_bf16(Bt[n][k], At[m][k], acc[ai][bj][m][n], 0, 0, 0); __builtin_amdgcn_s_setprio(0); } while (0)
#define PG8_WAIT_V(n) asm volatile("s_waitcnt vmcnt(" #n ")" ::: "memory")
#define PG8_WAIT_L(n) asm volatile("s_waitcnt lgkmcnt(" #n ")" ::: "memory")
#define PG8_BAR __builtin_amdgcn_s_barrier()
#define PG8_SCHED __builtin_amdgcn_sched_barrier(0)
    Unit cur, nxt; int ui = 0;
    if (!S.next(0, cur)) return;
    f32x4 acc[2][2][4][2];
#pragma unroll
    for (int a = 0; a < 2; ++a)
#pragma unroll
        for (int b = 0; b < 2; ++b)
#pragma unroll
            for (int m = 0; m < 4; ++m)
#pragma unroll
                for (int n = 0; n < 2; ++n) acc[a][b][m][n] = (f32x4){0.f, 0.f, 0.f, 0.f};
    bf16x8 At[4][2], B0[2][2], B1[2][2];
    const char* cA = (const char*)g.A + (size_t)cur.pm * tstep; const char* cB = (const char*)g.Bt + (size_t)cur.pn * tstep;
    S.a_ready(cur);
    if constexpr (SP2) {
        PG8_STAGE(PG8_SB(0, 0), cB, voffB); PG8_STAGE(PG8_SB(0, 1), cB + hstep, voffB); PG8_STAGE(PG8_SA(0, 0), cA, voffA); PG8_STAGE(PG8_SA(0, 1), cA + hstep, voffA);
        if (wr == 1) PG8_BAR;
        PG8_WAIT_V(2); PG8_BAR;
        PG8_STAGE(PG8_SB(1, 0), cB + kstep, voffB); PG8_STAGE(PG8_SA(1, 0), cA + kstep, voffA); PG8_STAGE(PG8_SB(1, 1), cB + hstep + kstep, voffB);
        PG8_WAIT_V(6); PG8_BAR;
    } else {
        PG8_STAGE(PG8_SB(0, 0), cB, voffB); PG8_STAGE(PG8_SA(0, 0), cA, voffA); PG8_STAGE(PG8_SB(0, 1), cB + hstep, voffB); PG8_STAGE(PG8_SA(0, 1), cA + hstep, voffA);
        if (wr == 1) PG8_BAR;
        PG8_WAIT_V(4); PG8_BAR;
        PG8_STAGE(PG8_SB(1, 0), cB + kstep, voffB); PG8_STAGE(PG8_SA(1, 0), cA + kstep, voffA); PG8_STAGE(PG8_SB(1, 1), cB + hstep + kstep, voffB);
        PG8_WAIT_V(6); PG8_BAR;
    }
    for (;;) {
        const bool has_next = S.next(ui + 1, nxt);
        const char* nA = has_next ? (const char*)g.A + (size_t)nxt.pm * tstep : cA; const char* nB = has_next ? (const char*)g.Bt + (size_t)nxt.pn * tstep : cB;
        for (int t = 0; t < nt; t += 2) {
            const bool last = (t == nt - 2);
            const char* a1 = cA + (size_t)(t + 1) * kstep;
            const char* a2 = last ? nA : cA + (size_t)(t + 2) * kstep; const char* b2 = last ? nB : cB + (size_t)(t + 2) * kstep;
            const char* a3 = a2 + kstep; const char* b3 = b2 + kstep;
            if (last && has_next) S.a_ready(nxt);
            if constexpr (SP2) {
            PG8_LDB(B0, 0, 0); PG8_LDB(B1, 0, 1); PG8_SCHED; PG8_LDA(At, 0, 0); PG8_STAGE(PG8_SA(1, 1), a1 + hstep, voffA);
            PG8_WAIT_V(8); PG8_WAIT_L(0); PG8_BAR; PG8_MMA(0, 0, At, B0); PG8_MMA(0, 1, At, B1); PG8_BAR; PG8_SCHED;
            PG8_LDA(At, 0, 1); PG8_STAGE(PG8_SB(0, 0), b2, voffB); PG8_STAGE(PG8_SB(0, 1), b2 + hstep, voffB); PG8_STAGE(PG8_SA(0, 0), a2, voffA);
            PG8_WAIT_V(8); PG8_WAIT_L(0); PG8_BAR; PG8_MMA(1, 0, At, B0); PG8_MMA(1, 1, At, B1); PG8_BAR; PG8_SCHED;
            PG8_LDB(B0, 1, 0); PG8_LDB(B1, 1, 1); PG8_SCHED; PG8_LDA(At, 1, 0); PG8_STAGE(PG8_SA(0, 1), a2 + hstep, voffA);
            PG8_WAIT_V(8); PG8_WAIT_L(0); PG8_BAR; PG8_MMA(0, 0, At, B0); PG8_MMA(0, 1, At, B1); PG8_BAR; PG8_SCHED;
            PG8_LDA(At, 1, 1); PG8_STAGE(PG8_SB(1, 0), b3, voffB); PG8_STAGE(PG8_SB(1, 1), b3 + hstep, voffB); PG8_STAGE(PG8_SA(1, 0), a3, voffA);
            PG8_WAIT_V(8); PG8_WAIT_L(0); PG8_BAR; PG8_MMA(1, 0, At, B0); PG8_MMA(1, 1, At, B1); PG8_BAR; PG8_SCHED;
            } else {
            PG8_LDB(B0, 0, 0); PG8_SCHED; PG8_LDA(At, 0, 0); PG8_STAGE(PG8_SA(1, 1), a1 + hstep, voffA);
            PG8_WAIT_L(8); PG8_BAR; PG8_WAIT_L(0); PG8_MMA(0, 0, At, B0); PG8_BAR; PG8_SCHED;
            PG8_LDB(B1, 0, 1); PG8_STAGE(PG8_SB(0, 0), b2, voffB);
            PG8_BAR; PG8_WAIT_L(0); PG8_MMA(0, 1, At, B1); PG8_BAR;
            PG8_LDA(At, 0, 1); PG8_STAGE(PG8_SA(0, 0), a2, voffA);
            PG8_BAR; PG8_WAIT_L(0); PG8_MMA(1, 0, At, B0); PG8_BAR; PG8_SCHED;
            PG8_STAGE(PG8_SB(0, 1), b2 + hstep, voffB);
            PG8_WAIT_V(6); PG8_BAR; PG8_MMA(1, 1, At, B1); PG8_BAR;
            PG8_LDB(B0, 1, 0); PG8_SCHED; PG8_LDA(At, 1, 0); PG8_STAGE(PG8_SA(0, 1), a2 + hstep, voffA);
            PG8_WAIT_L(8); PG8_BAR; PG8_WAIT_L(0); PG8_MMA(0, 0, At, B0); PG8_BAR; PG8_SCHED;
            PG8_LDB(B1, 1, 1); PG8_STAGE(PG8_SB(1, 0), b3, voffB);
            PG8_BAR; PG8_WAIT_L(0); PG8_MMA(0, 1, At, B1); PG8_BAR;
            PG8_LDA(At, 1, 1); PG8_STAGE(PG8_SA(1, 0), a3, voffA);
            PG8_BAR; PG8_WAIT_L(0); PG8_MMA(1, 0, At, B0); PG8_BAR; PG8_SCHED;
            PG8_STAGE(PG8_SB(1, 1), b3 + hstep, voffB);
            PG8_WAIT_V(6); PG8_BAR; PG8_MMA(1, 1, At, B1); PG8_BAR;
            }
        }
        if constexpr (ALIGN_EPI) { if (wr == 0) PG8_BAR; }
        if constexpr (!Epi::AFTER_DRAIN) { E(acc, cur, wr, wc, fr, fq); S.done(cur); }
        if (!has_next) break;
#pragma unroll
        for (int a = 0; a < 2; ++a)
#pragma unroll
            for (int b = 0; b < 2; ++b)
#pragma unroll
                for (int m = 0; m < 4; ++m)
#pragma unroll
                    for (int n = 0; n < 2; ++n) acc[a][b][m][n] = (f32x4){0.f, 0.f, 0.f, 0.f};
        cur = nxt; cA = nA; cB = nB; ++ui;
        if constexpr (ALIGN_EPI) { if (wr == 1) PG8_BAR; }
    }
    PG8_WAIT_V(0);
    if constexpr (!ALIGN_EPI) { if (wr == 0) PG8_BAR; }
    PG8_BAR;
    if constexpr (Epi::AFTER_DRAIN) { E.fused(acc, cur, wr, wc, fr, fq, lds, wid, lane); S.done(cur); }
#undef PG8_SA
#undef PG8_SB
#undef PG8_STAGE
#undef PG8_LDA
#undef PG8_LDB
#undef PG8_MMA
#undef PG8_WAIT_V
#undef PG8_WAIT_L
#undef PG8_BAR
#undef PG8_SCHED
}
}

#define LAS __attribute__((address_space(3)))
typedef unsigned short bf16;
typedef unsigned v4u __attribute__((ext_vector_type(4)));
typedef unsigned v2u __attribute__((ext_vector_type(2)));
typedef float f32x4 __attribute__((ext_vector_type(4)));
typedef float f32x2 __attribute__((ext_vector_type(2)));
typedef short bf16x8 __attribute__((ext_vector_type(8)));

constexpr int T = 16896, TP = 16384, DM = 1024, NSEQ_P = 8, SEQ = 2048, NSEQ_S = 128;
constexpr int GIN = 4112, GINP = 4352, SIN = 5152, SINP = 5376, DFF = 2816, CONVD = 3072;
constexpr float EPS = 1e-6f;
constexpr int LDS_BYTES = 147456;
constexpr size_t MiB = 1u << 20;
constexpr size_t WS_WGIN = 0, WS_WGOUT = 17 * MiB, WS_WSIN = 21 * MiB, WS_WSOUT = 42 * MiB, WS_WGU = 50 * MiB, WS_WDN = 94 * MiB, WS_HN = 116 * MiB,
                 WS_PROJ = 149 * MiB, WS_ACT = WS_PROJ, WS_QKV = 323 * MiB, WS_GB = 422 * MiB, WS_CH = 425 * MiB, WS_GLAST = 569 * MiB, WS_OBUF = 570 * MiB,
                 WS_SSQ = 636 * MiB, WS_GOUT = 639 * MiB, WS_BAR = 705 * MiB, WS_END = 706 * MiB;
constexpr size_t O_Y = 0, O_GSP = (size_t)T * DM, O_GCP = O_GSP + 2ull * 8 * 8 * 128 * 128, O_SHP = O_GCP + 2ull * 8 * 3 * CONVD, O_SCP = O_SHP + 2ull * 8 * 32 * 64 * 128,
                 O_GSS = O_SCP + 2ull * 8 * 3 * CONVD, O_GCS = O_GSS + 2ull * 128 * 8 * 128 * 128, O_SHS = O_GCS + 2ull * 128 * 3 * CONVD, O_SCS = O_SHS + 2ull * 128 * 32 * 64 * 128,
                 O_END = O_SCS + 2ull * 128 * 3 * CONVD;
static_assert(O_END == 129269760ull, "output size");
constexpr int OFF_U = 0, OFF_W = 8192, OFF_QG = 16384, OFF_KDT = 24576, OFF_ATTN = 32768, CHU = 36864;

struct Args { const float* in[27]; float* out; unsigned char* ws; int ph_lo, ph_hi; };

__device__ __forceinline__ float bf2f(unsigned short h) { return __uint_as_float((unsigned)h << 16); }
__device__ __forceinline__ float bflo(unsigned u) { return __uint_as_float(u << 16); }
__device__ __forceinline__ float bfhi(unsigned u) { return __uint_as_float(u & 0xffff0000u); }
__device__ __forceinline__ unsigned pk2(float lo, float hi) { return pg8::cvt_pk_bf16(lo, hi); }
__device__ __forceinline__ unsigned short f2bf(float f) { return (unsigned short)(pg8::cvt_pk_bf16(f, 0.f) & 0xffffu); }
__device__ __forceinline__ float silu_f(float x) { return x * __builtin_amdgcn_rcpf(1.0f + __expf(-x)); }
__device__ __forceinline__ float sigmoid_f(float x) { return __builtin_amdgcn_rcpf(1.0f + __expf(-x)); }
__device__ __forceinline__ float softplus_f(float x) { return fmaxf(x, 0.f) + log1pf(__expf(-fabsf(x))); }
template <int M> __device__ __forceinline__ float shx(float v, int lane) {
    if constexpr (M < 32) return __int_as_float(__builtin_amdgcn_ds_swizzle(__float_as_int(v), (M << 10) | 0x1f));
    else return __int_as_float(__builtin_amdgcn_ds_bpermute((lane ^ 32) << 2, __float_as_int(v)));
}
__device__ __forceinline__ float shi(float v, int src) { return __int_as_float(__builtin_amdgcn_ds_bpermute(src << 2, __float_as_int(v))); }
__device__ __forceinline__ float wave_sum(int lane, float v) {
    v += shx<1>(v, lane); v += shx<2>(v, lane); v += shx<4>(v, lane); v += shx<8>(v, lane); v += shx<16>(v, lane); v += shx<32>(v, lane);
    return v;
}
__device__ __forceinline__ float wave_incl_scan(float v, int lane) {
#pragma unroll
    for (int d = 1; d < 64; d <<= 1) { const float t = shi(v, lane - d); if (lane >= d) v += t; }
    return v;
}
#define REP_BARRIER 0
#ifndef REP_PROMPT
#define REP_PROMPT 1
#endif
__device__ __forceinline__ int tsw_w(int row, int j) { return row * 144 + ((((j >> 3) ^ (row >> 3)) & 7) << 4) + ((j & 7) << 1); }
__device__ __forceinline__ int tsw_r(int row, int gran) { return row * 144 + (((gran ^ (row >> 3)) & 7) << 4); }
__device__ __forceinline__ void st16_wt(void* p, v4u v) { asm volatile("global_store_dwordx4 %0, %1, off sc1\n\ts_nop 1" :: "v"(p), "v"(v) : "memory"); }
#define RLX_AGENT_ __ATOMIC_RELAXED, __HIP_MEMORY_SCOPE_AGENT
__device__ __forceinline__ void wait_flag_set(unsigned* flag, unsigned seen) {
    unsigned v = seen, spins = 0;
    while (__builtin_amdgcn_readfirstlane(v) == 0u && spins < (1u << 22)) { __builtin_amdgcn_s_sleep(2); v = __hip_atomic_load(flag, RLX_AGENT_); ++spins; }
}
#define MFMA16(a, b, c) __builtin_amdgcn_mfma_f32_16x16x32_bf16((a), (b), (c), 0, 0, 0)
#define LDS_WAIT() asm volatile("s_waitcnt lgkmcnt(0)" ::: "memory")
#define BAR_LDS() do { asm volatile("s_waitcnt lgkmcnt(0)" ::: "memory"); __builtin_amdgcn_s_barrier(); asm volatile("" ::: "memory"); } while (0)

#define XB_TMO      128
#define XB_XCNT(j)  (256  + 64 * (j))
#define XB_XSUB(j)  (1280 + 64 * (j))
#define XB_XGEN(j)  (2304 + 64 * (j))
#define XB_TOP      3328
#define XB_TOPGEN   3392
#define XCD_BAR_WORDS 3456
#define XB_SPIN_CAP (1u << 18)

__device__ __forceinline__ unsigned xb_ld(unsigned* p)              { return __hip_atomic_load(p, __ATOMIC_RELAXED, __HIP_MEMORY_SCOPE_AGENT); }
__device__ __forceinline__ unsigned xb_add(unsigned* p, unsigned v) { return __hip_atomic_fetch_add(p, v, __ATOMIC_RELAXED, __HIP_MEMORY_SCOPE_AGENT); }
__device__ __forceinline__ unsigned xb_xcc_id() { return (unsigned)__builtin_amdgcn_s_getreg((3 << 11) | 20) & 0xFu; }
#define XB_SPIN(cond, bar) do { unsigned _sp = 0; while (cond) { __builtin_amdgcn_s_sleep(1); \
    if ((++_sp & 255u) == 0u) { if (xb_ld(&(bar)[XB_TMO])) break; if (_sp > XB_SPIN_CAP) { atomicAdd(&(bar)[XB_TMO], 1u); break; } } } } while (0)

struct XcdBarrier {
    unsigned* bar; unsigned x;
    volatile LAS unsigned* st;
};

__device__ __forceinline__ XcdBarrier xcd_barrier_post(unsigned* bar, volatile LAS unsigned* st) {
    XcdBarrier b; b.bar = bar; b.x = xb_xcc_id(); b.st = st;
    if (threadIdx.x == 0) (void)xb_add(&bar[XB_XCNT(b.x)], 1u);
    return b;
}
__device__ __forceinline__ void xcd_barrier_complete(unsigned* bar, unsigned x, unsigned& nloc, unsigned& nx) {
    const unsigned G = gridDim.x * gridDim.y * gridDim.z;
    unsigned sum, cnt, mine, sp = 0u;
    for (;;) {
        sum = 0u; cnt = 0u; mine = 0u;
#pragma unroll
        for (unsigned j = 0; j < 16; ++j) { const unsigned c = xb_ld(&bar[XB_XCNT(j)]); sum += c; cnt += (c > 0u) ? 1u : 0u; mine = (j == x) ? c : mine; }
        if (sum == G) break;
        __builtin_amdgcn_s_sleep(1);
        if ((++sp & 255u) == 0u) { if (xb_ld(&bar[XB_TMO])) break; if (sp > XB_SPIN_CAP) { atomicAdd(&bar[XB_TMO], 1u); break; } }
    }
    nloc = mine > 0u ? mine : 1u; nx = cnt > 0u ? cnt : 1u;
}

__device__ __forceinline__ void xcd_barrier(const XcdBarrier& b) {
    asm volatile("s_waitcnt vmcnt(0)" ::: "memory");
    __syncthreads();
    if (threadIdx.x == 0) {
        unsigned* bar = b.bar;
        __builtin_amdgcn_s_waitcnt(0);
        unsigned nloc = b.st[0], nx = b.st[1];
        if (nloc == 0u) { xcd_barrier_complete(bar, b.x, nloc, nx); b.st[0] = nloc; b.st[1] = nx; }
        const unsigned old = xb_add(&bar[XB_XSUB(b.x)], 1u);
        const unsigned gen = old / nloc;
        if (old + 1u == (gen + 1u) * nloc) {
            __builtin_amdgcn_fence(__ATOMIC_RELEASE, "agent");
            asm volatile("s_waitcnt vmcnt(0)" ::: "memory");
            const unsigned og = xb_add(&bar[XB_TOP], 1u);
            const unsigned tg = og / nx;
            if (og + 1u == (tg + 1u) * nx) xb_add(&bar[XB_TOPGEN], 1u);
            else XB_SPIN(xb_ld(&bar[XB_TOPGEN]) == tg, bar);
            __builtin_amdgcn_fence(__ATOMIC_ACQUIRE, "agent");
            xb_add(&bar[XB_XGEN(b.x)], 1u);
            asm volatile("s_waitcnt vmcnt(0)" ::: "memory");
        } else {
            XB_SPIN(xb_ld(&bar[XB_XGEN(b.x)]) == gen, bar);
            __builtin_amdgcn_fence(__ATOMIC_ACQUIRE, "agent");
            asm volatile("s_waitcnt vmcnt(0)" ::: "memory");
        }
    }
    __syncthreads();
}


__device__ __forceinline__ void tr_item(const float* __restrict__ W, int K, int N, bf16* WT, const float* __restrict__ ks, int mode, LAS float* scr, int item, int nblk, int lane) {
    const int kb = item / nblk, nb = item - kb * nblk, k0 = 64 * kb, n0 = 64 * nb;
    const int nn = n0 + 4 * (lane & 15); const bool ok = nn < N;
    f32x4 v[16];
#pragma unroll
    for (int i = 0; i < 16; ++i) { const int kk = 4 * i + (lane >> 4); v[i] = ok ? *(const f32x4*)(W + (size_t)(k0 + kk) * N + nn) : (f32x4){0.f, 0.f, 0.f, 0.f}; }
    if (ks) {
#pragma unroll
        for (int i = 0; i < 16; ++i) v[i] = v[i] * ks[k0 + 4 * i + (lane >> 4)];
    }
#pragma unroll
    for (int i = 0; i < 16; ++i) { const int kk = 4 * i + (lane >> 4); LAS float* d = scr + kk * 65 + 4 * (lane & 15); d[0] = v[i].x; d[1] = v[i].y; d[2] = v[i].z; d[3] = v[i].w; }
    LDS_WAIT();
    const int c = lane & 7;
#pragma unroll
    for (int jx = 0; jx < 8; ++jx) { const int n = (lane >> 3) + 8 * jx; const LAS float* sp = scr + (8 * c) * 65 + n;
        v4u o; o.x = pk2(sp[0 * 65], sp[1 * 65]); o.y = pk2(sp[2 * 65], sp[3 * 65]); o.z = pk2(sp[4 * 65], sp[5 * 65]); o.w = pk2(sp[6 * 65], sp[7 * 65]);
        const int nr = n0 + n; const int dr = mode == 0 ? nr : (((nr >> 7) << 8) + (nr & 127) + (mode == 2 ? 128 : 0));
        *(v4u*)(WT + (size_t)dr * K + k0 + 8 * c) = o; }
    LDS_WAIT();
}
constexpr int I_GIN = 16 * (GINP / 64), I_GOUT = 16 * 16, I_SIN = 16 * (SINP / 64), I_SOUT = 32 * 16, I_GU = 16 * (DFF / 64), I_DN = (DFF / 64) * 16;
constexpr int O_GIN = 0, O_GOUT = 2 * I_GIN, O_SIN = O_GOUT + 2 * I_GOUT, O_SOUT = O_SIN + 2 * I_SIN, O_GU = O_SOUT + 2 * I_SOUT, O_DN = O_GU + 8 * I_GU;
__device__ __forceinline__ void cvt_item(const Args& a, LAS float* scr, int it, int lane) {
    unsigned char* ws = a.ws; int r = it;
    if (r < 2 * I_GIN) { const int j = r / I_GIN; r -= j * I_GIN; tr_item(a.in[10] + (size_t)j * DM * GIN, DM, GIN, (bf16*)(ws + WS_WGIN) + (size_t)j * GINP * DM, a.in[6] + (2 * j) * DM, 0, scr, r, GINP / 64, lane); return; }
    r -= 2 * I_GIN;
    if (r < 2 * I_GOUT) { const int j = r / I_GOUT; r -= j * I_GOUT; tr_item(a.in[15] + (size_t)j * DM * DM, DM, DM, (bf16*)(ws + WS_WGOUT) + (size_t)j * DM * DM, nullptr, 0, scr, r, DM / 64, lane); return; }
    r -= 2 * I_GOUT;
    if (r < 2 * I_SIN) { const int j = r / I_SIN; r -= j * I_SIN; tr_item(a.in[16] + (size_t)j * DM * SIN, DM, SIN, (bf16*)(ws + WS_WSIN) + (size_t)j * SINP * DM, a.in[6] + (2 * j + 1) * DM, 0, scr, r, SINP / 64, lane); return; }
    r -= 2 * I_SIN;
    if (r < 2 * I_SOUT) { const int j = r / I_SOUT; r -= j * I_SOUT; tr_item(a.in[23] + (size_t)j * 2048 * DM, 2048, DM, (bf16*)(ws + WS_WSOUT) + (size_t)j * DM * 2048, a.in[22] + j * 2048, 0, scr, r, DM / 64, lane); return; }
    r -= 2 * I_SOUT;
    if (r < 8 * I_GU) { const int q = r / I_GU; r -= q * I_GU; const int i = q >> 1, up = q & 1;
        tr_item(a.in[up ? 25 : 24] + (size_t)i * DM * DFF, DM, DFF, (bf16*)(ws + WS_WGU) + (size_t)i * 2 * DFF * DM, a.in[8] + i * DM, up ? 2 : 1, scr, r, DFF / 64, lane); return; }
    r -= 8 * I_GU;
    { const int i = r / I_DN; r -= i * I_DN; tr_item(a.in[26] + (size_t)i * DFF * DM, DFF, DM, (bf16*)(ws + WS_WDN) + (size_t)i * DM * DFF, nullptr, 0, scr, r, DM / 64, lane); }
}
constexpr int CV_NR = 16;
constexpr int CV_ST[CV_NR] = {O_GIN, O_GOUT, O_GU, O_DN,   O_SIN, O_SOUT, O_GU + 2 * I_GU, O_DN + I_DN,   O_GIN + I_GIN, O_GOUT + I_GOUT, O_GU + 4 * I_GU, O_DN + 2 * I_DN,   O_SIN + I_SIN, O_SOUT + I_SOUT, O_GU + 6 * I_GU, O_DN + 3 * I_DN};
constexpr int CV_LN[CV_NR] = {I_GIN, I_GOUT, 2 * I_GU, I_DN,   I_SIN, I_SOUT, 2 * I_GU, I_DN,   I_GIN, I_GOUT, 2 * I_GU, I_DN,   I_SIN, I_SOUT, 2 * I_GU, I_DN};
constexpr int CV_N0 = I_GIN + I_GOUT + 2 * I_GU + I_DN;
constexpr int CV_TOTAL = 2 * (I_GIN + I_GOUT + I_SIN + I_SOUT) + 4 * (2 * I_GU + I_DN);
__host__ __device__ constexpr int CV_WB(int w) { return w <= 0 ? 0 : w == 1 ? 2200 : w == 2 ? 3350 : w == 3 ? 5450 : w == 4 ? 6600 : w == 5 ? 8800 : w == 6 ? 9950 : (CV_TOTAL - CV_N0); }
static_assert(CV_TOTAL - CV_N0 == 11392, "conversion item count");
__device__ __forceinline__ void phase_convert(const Args& a, LAS unsigned char* lds, int lo, int hi, int worker, int nworkers, int wave, int lane) {
    LAS float* scr = (LAS float*)(lds + wave * 16640);
    for (int v = lo + worker; v < hi; v += nworkers) {
        int r = v, it = 0; bool done = false;
#pragma unroll
        for (int rr = 0; rr < CV_NR; ++rr) { if (!done) { if (r < CV_LN[rr]) { it = CV_ST[rr] + r; done = true; } else r -= CV_LN[rr]; } }
        cvt_item(a, scr, it, lane);
    }
}
__device__ __forceinline__ void phase_prologue(const Args& a, LAS unsigned char* lds, int wave, int lane, int bid, int G) {
    const int gw = bid * 8 + wave, NGW = G * 8;
    unsigned char* ws = a.ws;
    bf16* hn = (bf16*)(ws + WS_HN);
    for (int m = gw; m < T; m += NGW) {
        const float* xrow = m < TP ? a.in[0] + (size_t)m * DM : a.in[1] + (size_t)(m - TP) * DM;
        f32x4 v[4]; float s = 0.f;
#pragma unroll
        for (int jx = 0; jx < 4; ++jx) { v[jx] = *(const f32x4*)(xrow + 4 * lane + 256 * jx); s += (v[jx].x * v[jx].x + v[jx].y * v[jx].y) + (v[jx].z * v[jx].z + v[jx].w * v[jx].w); }
        const float rstd = rsqrtf(wave_sum(lane, s) * (1.f / DM) + EPS);
#pragma unroll
        for (int jx = 0; jx < 4; ++jx) { v2u o; o.x = pk2(v[jx].x * rstd, v[jx].y * rstd); o.y = pk2(v[jx].z * rstd, v[jx].w * rstd); *(v2u*)(hn + (size_t)m * DM + 4 * lane + 256 * jx) = o; }
    }
}

__device__ __forceinline__ void phase_res(const Args& a, int L, bool ffn, int m_lo, int m_hi, int gw, int NGW, int lane, const bf16* gout2, int np2) {
    const bf16* gout = (const bf16*)(a.ws + WS_GOUT);
    const float* postw = (ffn ? a.in[9] : a.in[7]) + L * DM;
    const bool ssd_mix = !ffn && (L & 1);
    const bool first = !ffn && L == 0;
    const float* ssq = (const float*)(a.ws + WS_SSQ);
    bf16* hn = (bf16*)(a.ws + WS_HN);
    f32x4 pw[4];
#pragma unroll
    for (int jx = 0; jx < 4; ++jx) pw[jx] = *(const f32x4*)(postw + 4 * lane + 256 * jx);
    float* sc = (float*)(a.ws + WS_GLAST + 262144);
    const bool last = ffn && L == 3;
    v2u og[4], og2[4], hr[4]; f32x4 xf[4]; float xs_n = 1.f, p_n = 0.f;
#define RES_LOAD(mm) do { const int m_ = (mm);         _Pragma("unroll") for (int jx = 0; jx < 4; ++jx) { og[jx] = *(const v2u*)(gout + (size_t)m_ * DM + 4 * lane + 256 * jx);             if (gout2) og2[jx] = *(const v2u*)(gout2 + (size_t)m_ * DM + 4 * lane + 256 * jx);             if (first) xf[jx] = *(const f32x4*)((m_ < TP ? a.in[0] + (size_t)m_ * DM : a.in[1] + (size_t)(m_ - TP) * DM) + 4 * lane + 256 * jx);             else hr[jx] = *(const v2u*)(hn + (size_t)m_ * DM + 4 * lane + 256 * jx); }         if (!first) xs_n = sc[m_];         if (ssd_mix) p_n = lane < 32 ? ssq[(size_t)m_ * 32 + lane] : 0.f; } while (0)
    int m = m_lo + gw;
    if (m < m_hi) RES_LOAD(m);
    for (; m < m_hi; m += NGW) {
        f32x4 o[4], x[4]; float ss = 0.f; const float xs = first ? 1.f : xs_n; float p = p_n;
#pragma unroll
        for (int jx = 0; jx < 4; ++jx) { o[jx] = (f32x4){bflo(og[jx].x), bfhi(og[jx].x), bflo(og[jx].y), bfhi(og[jx].y)};
            if (gout2) { o[jx] = o[jx] + (f32x4){bflo(og2[jx].x), bfhi(og2[jx].x), bflo(og2[jx].y), bfhi(og2[jx].y)};
                for (int e = 1; e < np2; ++e) { const v2u g3 = *(const v2u*)(gout2 + (size_t)e * (T - TP) * DM + (size_t)m * DM + 4 * lane + 256 * jx); o[jx] = o[jx] + (f32x4){bflo(g3.x), bfhi(g3.x), bflo(g3.y), bfhi(g3.y)}; } }
            if (first) x[jx] = xf[jx]; else x[jx] = (f32x4){bflo(hr[jx].x), bfhi(hr[jx].x), bflo(hr[jx].y), bfhi(hr[jx].y)};
            ss += (o[jx].x * o[jx].x + o[jx].y * o[jx].y) + (o[jx].z * o[jx].z + o[jx].w * o[jx].w); }
        RES_LOAD(m + NGW < m_hi ? m + NGW : m);
        float eps_eff = EPS;
        if (ssd_mix) { p = wave_sum(lane, p); eps_eff = EPS * (p * (1.f / 2048.f) + EPS); }
        const float r1 = rsqrtf(wave_sum(lane, ss) * (1.f / DM) + eps_eff);
        float s2 = 0.f;
#pragma unroll
        for (int jx = 0; jx < 4; ++jx) { x[jx] = x[jx] * xs + o[jx] * r1 * pw[jx]; s2 += (x[jx].x * x[jx].x + x[jx].y * x[jx].y) + (x[jx].z * x[jx].z + x[jx].w * x[jx].w);
            if (last) *(f32x4*)(a.out + (size_t)m * DM + 4 * lane + 256 * jx) = x[jx]; }
        const float s2m = wave_sum(lane, s2) * (1.f / DM) + EPS; const float r2 = rsqrtf(s2m);
        if (!last) {
#pragma unroll
            for (int jx = 0; jx < 4; ++jx) { v2u w; w.x = pk2(x[jx].x * r2, x[jx].y * r2); w.y = pk2(x[jx].z * r2, x[jx].w * r2); *(v2u*)(hn + (size_t)m * DM + 4 * lane + 256 * jx) = w; }
            if (lane == 0) sc[m] = s2m * r2;
        }
    }
#undef RES_LOAD
}

template <bool GDN>
__device__ __forceinline__ void phase_conv(const Args& a, int j, int wave, int lane, int bid, int G) {
    const int gw = bid * 8 + wave, NGW = G * 8;
    const bf16* proj = (const bf16*)(a.ws + WS_PROJ); const int ldc = GDN ? GINP : SINP; const int pc0 = GDN ? 0 : 2048;
    bf16* qkv = (bf16*)(a.ws + WS_QKV);
    const float* cw = (GDN ? a.in[11] : a.in[17]) + (size_t)j * 4 * CONVD;
    const float* cb = a.in[18] + (size_t)j * CONVD;
    const float* cst = (GDN ? a.in[3] : a.in[5]) + (size_t)j * NSEQ_S * 3 * CONVD;
    float* ocp = a.out + (GDN ? O_GCP : O_SCP) + (size_t)j * NSEQ_P * 3 * CONVD;
    float* ocs = a.out + (GDN ? O_GCS : O_SCS) + (size_t)j * NSEQ_S * 3 * CONVD;
    constexpr int NPI = (TP / 16) * 6, NSI = NSEQ_S * 6;
    for (int it = gw; it < NPI + NSI; it += NGW) {
        const bool samp = it >= NPI; const int r = samp ? it - NPI : it; const int sec = r % 6, rb = r / 6;
        const int c = sec * 512 + 8 * lane;
        float w[4][8], bias[8], xa[8], xb[8], xc[8];
#pragma unroll
        for (int jj = 0; jj < 4; ++jj) { const f32x4 wl = *(const f32x4*)(cw + jj * CONVD + c), wh = *(const f32x4*)(cw + jj * CONVD + c + 4);
            w[jj][0] = wl.x; w[jj][1] = wl.y; w[jj][2] = wl.z; w[jj][3] = wl.w; w[jj][4] = wh.x; w[jj][5] = wh.y; w[jj][6] = wh.z; w[jj][7] = wh.w; }
#pragma unroll
        for (int e = 0; e < 8; ++e) bias[e] = GDN ? 0.f : cb[c + e];
        int m0, nrows, bq = 0, t0 = 0;
#define CV_UNPACK(dst, q) do { dst[0] = bflo(q.x); dst[1] = bfhi(q.x); dst[2] = bflo(q.y); dst[3] = bfhi(q.y); dst[4] = bflo(q.z); dst[5] = bfhi(q.z); dst[6] = bflo(q.w); dst[7] = bfhi(q.w); } while (0)
        if (!samp) { bq = rb >> 7; t0 = (rb & 127) * 16; m0 = bq * SEQ + t0; nrows = 16;
            if (t0 != 0) { const v4u ra = *(const v4u*)(proj + (size_t)(m0 - 3) * ldc + pc0 + c), rbb = *(const v4u*)(proj + (size_t)(m0 - 2) * ldc + pc0 + c), rc = *(const v4u*)(proj + (size_t)(m0 - 1) * ldc + pc0 + c);
                CV_UNPACK(xa, ra); CV_UNPACK(xb, rbb); CV_UNPACK(xc, rc); }
            else {
#pragma unroll
                for (int e = 0; e < 8; ++e) { xa[e] = 0.f; xb[e] = 0.f; xc[e] = 0.f; } }
        } else { m0 = TP + 4 * rb; nrows = 4;
#pragma unroll
            for (int hh = 0; hh < 2; ++hh) { const f32x4 va = *(const f32x4*)(cst + ((size_t)rb * 3 + 0) * CONVD + c + 4 * hh), vb = *(const f32x4*)(cst + ((size_t)rb * 3 + 1) * CONVD + c + 4 * hh), vc = *(const f32x4*)(cst + ((size_t)rb * 3 + 2) * CONVD + c + 4 * hh);
                xa[4 * hh] = va.x; xa[4 * hh + 1] = va.y; xa[4 * hh + 2] = va.z; xa[4 * hh + 3] = va.w; xb[4 * hh] = vb.x; xb[4 * hh + 1] = vb.y; xb[4 * hh + 2] = vb.z; xb[4 * hh + 3] = vb.w;
                xc[4 * hh] = vc.x; xc[4 * hh + 1] = vc.y; xc[4 * hh + 2] = vc.z; xc[4 * hh + 3] = vc.w; } }
        v4u rawv[16];
#pragma unroll
        for (int i = 0; i < 16; ++i) { const int ii = i < nrows ? i : nrows - 1; rawv[i] = *(const v4u*)(proj + (size_t)(m0 + ii) * ldc + pc0 + c); }
#pragma unroll
        for (int i = 0; i < 16; ++i) { if (i < nrows) {
            const v4u raw = rawv[i];
            float x[8], y[8]; CV_UNPACK(x, raw);
            float ss = 0.f;
#pragma unroll
            for (int e = 0; e < 8; ++e) { y[e] = silu_f(xa[e] * w[0][e] + xb[e] * w[1][e] + xc[e] * w[2][e] + x[e] * w[3][e] + bias[e]); ss += y[e] * y[e]; }
            if (GDN && sec < 4) { ss += shx<1>(ss, lane); ss += shx<2>(ss, lane); ss += shx<4>(ss, lane); ss += shx<8>(ss, lane);
                const float sc = rsqrtf(ss + 1e-6f) * (sec < 2 ? 0.08838834764831845f : 1.f);
#pragma unroll
                for (int e = 0; e < 8; ++e) y[e] *= sc; }
            v4u o; o.x = pk2(y[0], y[1]); o.y = pk2(y[2], y[3]); o.z = pk2(y[4], y[5]); o.w = pk2(y[6], y[7]);
            *(v4u*)(qkv + (size_t)(m0 + i) * CONVD + c) = o;
            float* cn = nullptr;
            if (!samp) { if (t0 + 16 == SEQ && i >= 13) cn = ocp + ((size_t)bq * 3 + (i - 13)) * CONVD + c; }
            else if (i >= 1) cn = ocs + ((size_t)rb * 3 + (i - 1)) * CONVD + c;
            if (cn) { *(f32x4*)cn = (f32x4){x[0], x[1], x[2], x[3]}; *(f32x4*)(cn + 4) = (f32x4){x[4], x[5], x[6], x[7]}; }
#pragma unroll
            for (int e = 0; e < 8; ++e) { xa[e] = xb[e]; xb[e] = xc[e]; xc[e] = x[e]; }
        } }
#undef CV_UNPACK
    }
    const int gt = bid * 512 + wave * 64 + lane, NT = G * 512;
    float* gb = (float*)(a.ws + WS_GB);
    if (GDN) {
        const float* Alog = a.in[12] + j * 8; const float* dtb = a.in[13] + j * 8;
        for (int idx = gt; idx < T * 8; idx += NT) { const int m = idx >> 3, h = idx & 7;
            const float bb = bf2f(proj[(size_t)m * ldc + 4096 + h]), aa = bf2f(proj[(size_t)m * ldc + 4104 + h]);
            gb[(size_t)m * 16 + h] = sigmoid_f(bb); gb[(size_t)m * 16 + 8 + h] = -__expf(Alog[h]) * softplus_f(aa + dtb[h]); }
    } else {
        const float* dtb = a.in[19] + j * 32;
        for (int idx = gt; idx < T * 32; idx += NT) { const int m = idx >> 5, h = idx & 31;
            gb[(size_t)m * 32 + h] = softplus_f(bf2f(proj[(size_t)m * ldc + 5120 + h]) + dtb[h]); }
    }
}

__device__ __forceinline__ void phase_gp(const Args& a, int jl, LAS unsigned char* lds, int tid, int wave, int lane, int bid, int G) {
    const bf16* qkv = (const bf16*)(a.ws + WS_QKV); const float* gb = (const float*)(a.ws + WS_GB);
    bf16* ch = (bf16*)(a.ws + WS_CH); float* glast = (float*)(a.ws + WS_GLAST);
    constexpr int MF = 0, GLo = 16384, BLo = 16640, EGo = 16896, QL = 17408, KL = 34816, VL = 52224;
    constexpr int XTo = 69632, ATOo = XTo + 36864, SCRo = ATOo + 8192;
    LAS unsigned short* ATOs = (LAS unsigned short*)(lds + ATOo);
    LAS float* GLf = (LAS float*)(lds + GLo); LAS float* BLf = (LAS float*)(lds + BLo); LAS float* EGf = (LAS float*)(lds + EGo); LAS float* MFf = (LAS float*)(lds + MF);
    const int fr = lane & 15, fq = lane >> 4;
    unsigned* gpflag = (unsigned*)(a.ws + WS_BAR + 16384) + jl * 2048;
    v4u pf[6]; float pbe = 0.f, pg_ = 0.f;
#define GP_PREF(qq) do { const int q_ = (qq); const int uid_ = (q_ & 63) * 32 + (q_ >> 6); const int n_ = uid_ & 31, bh_ = uid_ >> 5, h_ = bh_ & 7, b_ = bh_ >> 3; const int mm = b_ * SEQ + n_ * 64; \
        _Pragma("unroll") for (int r = 0; r < 6; ++r) { const int cidx = tid + 512 * r, sect = cidx >> 10, rem = cidx & 1023, row = rem >> 4, cc = rem & 15; \
            pf[r] = *(const v4u*)(qkv + (size_t)(mm + row) * CONVD + sect * 1024 + h_ * 128 + cc * 8); } \
        pbe = gb[(size_t)(mm + lane) * 16 + h_]; pg_ = gb[(size_t)(mm + lane) * 16 + 8 + h_]; } while (0)
    if (bid - 64 < 2048) GP_PREF(bid - 64);
    for (int q = bid - 64; q < 2048; q += G - 64) {
        const int uid = (q & 63) * 32 + (q >> 6);
        bf16* chu = ch + (size_t)uid * CHU;
#pragma unroll
        for (int r = 0; r < 6; ++r) { const int cidx = tid + 512 * r, sect = cidx >> 10, rem = cidx & 1023, row = rem >> 4, cc = rem & 15;
            *(LAS v4u*)(lds + QL + sect * 17408 + row * 272 + cc * 16) = pf[r]; }
        const float be = pbe, g = pg_;
        GP_PREF(q + G - 64 < 2048 ? q + G - 64 : q);
        if (wave == 0) { const float Gc = wave_incl_scan(g, lane);
            GLf[lane] = Gc; BLf[lane] = be; const float eg = __expf(Gc); EGf[lane] = eg; if (lane == 63) __hip_atomic_store((unsigned*)(glast + uid), __float_as_uint(eg), RLX_AGENT_); }
        BAR_LDS();
        {   const int mat = wave >> 2, tr = wave & 3;
            const LAS unsigned char* Ab = lds + (mat == 0 ? KL : QL);
            bf16x8 af[4];
#pragma unroll
            for (int kk = 0; kk < 4; ++kk) af[kk] = *(const LAS bf16x8*)(Ab + (tr * 16 + fr) * 272 + (kk * 32 + fq * 8) * 2);
#pragma unroll
            for (int tc = 0; tc < 4; ++tc) {
                const int jcol = tc * 16 + fr;
                if (tc <= tr) {
                    f32x4 acc = {0.f, 0.f, 0.f, 0.f};
#pragma unroll
                    for (int kk = 0; kk < 4; ++kk) { const bf16x8 bfr = *(const LAS bf16x8*)(lds + KL + (tc * 16 + fr) * 272 + (kk * 32 + fq * 8) * 2); acc = MFMA16(af[kk], bfr, acc); }
                    const float Gj = GLf[jcol];
#pragma unroll
                    for (int r = 0; r < 4; ++r) { const int i = tr * 16 + fq * 4 + r; const float Gi = GLf[i];
                        const float e = (i >= jcol) ? __expf(Gi - Gj) : 0.f;
                        if (mat == 0) MFf[i * 64 + jcol] = (i > jcol) ? BLf[i] * acc[r] * e : 0.f;
                        else ATOs[i * 64 + jcol] = f2bf(acc[r] * e); }
                } else if (mat == 1) {
#pragma unroll
                    for (int r = 0; r < 4; ++r) { const int i = tr * 16 + fq * 4 + r; ATOs[i * 64 + jcol] = 0; }
                }
            }
        }
        BAR_LDS();
        if (tid < 256) {
            const bool isU = tid < 128; const int cc = tid & 127;
            const LAS unsigned char* src = lds + (isU ? VL : KL);
            LAS unsigned char* xt = lds + XTo + tid * 144;
            LAS unsigned char* scr = lds + SCRo + wave * 5120;
            float rr[16];
#pragma unroll
            for (int ib = 0; ib < 4; ++ib) {
                const int i0 = 16 * ib;
#pragma unroll
                for (int r = 0; r < 16; ++r) { const float egi = EGf[i0 + r]; rr[r] = bf2f(*(const LAS unsigned short*)(src + (i0 + r) * 272 + cc * 2)) * BLf[i0 + r] * (isU ? 1.0f : egi); }
                if (ib > 0) {
                    const bool v0 = 8 * fq < i0;
                    bf16x8 a0 = {0, 0, 0, 0, 0, 0, 0, 0}, a1 = {0, 0, 0, 0, 0, 0, 0, 0};
                    if (v0) { const f32x4 m0 = *(const LAS f32x4*)(lds + MF + ((i0 + fr) * 64 + 8 * fq) * 4), m1 = *(const LAS f32x4*)(lds + MF + ((i0 + fr) * 64 + 8 * fq + 4) * 4);
                        v4u p; p.x = pk2(m0.x, m0.y); p.y = pk2(m0.z, m0.w); p.z = pk2(m1.x, m1.y); p.w = pk2(m1.z, m1.w); a0 = __builtin_bit_cast(bf16x8, p); }
                    if (ib == 3 && fq < 2) { const f32x4 m0 = *(const LAS f32x4*)(lds + MF + ((i0 + fr) * 64 + 32 + 8 * fq) * 4), m1 = *(const LAS f32x4*)(lds + MF + ((i0 + fr) * 64 + 32 + 8 * fq + 4) * 4);
                        v4u p; p.x = pk2(m0.x, m0.y); p.y = pk2(m0.z, m0.w); p.z = pk2(m1.x, m1.y); p.w = pk2(m1.z, m1.w); a1 = __builtin_bit_cast(bf16x8, p); }
#pragma unroll
                    for (int t = 0; t < 4; ++t) {
                        const LAS unsigned char* xc = lds + XTo + (wave * 64 + t * 16 + fr) * 144;
                        bf16x8 b0 = {0, 0, 0, 0, 0, 0, 0, 0};
                        if (v0) b0 = *(const LAS bf16x8*)(xc + 16 * fq);
                        f32x4 acc = {0.f, 0.f, 0.f, 0.f};
                        acc = MFMA16(a0, b0, acc);
                        if (ib == 3) { bf16x8 b1 = {0, 0, 0, 0, 0, 0, 0, 0}; if (fq < 2) b1 = *(const LAS bf16x8*)(xc + 64 + 16 * fq); acc = MFMA16(a1, b1, acc); }
                        *(LAS f32x4*)(scr + (t * 16 + fr) * 80 + 16 * fq) = acc;
                    }
                    LDS_WAIT();
#pragma unroll
                    for (int q4 = 0; q4 < 4; ++q4) { const f32x4 d = *(const LAS f32x4*)(scr + lane * 80 + 16 * q4); rr[4 * q4] -= d.x; rr[4 * q4 + 1] -= d.y; rr[4 * q4 + 2] -= d.z; rr[4 * q4 + 3] -= d.w; }
                    LDS_WAIT();
                }
#pragma unroll
                for (int rb = 0; rb < 4; ++rb) {
#pragma unroll
                    for (int r = 4 * rb; r < 4 * rb + 4; ++r) {
#pragma unroll
                        for (int r2 = 0; r2 < r; ++r2) rr[r] -= MFf[(i0 + r) * 64 + i0 + r2] * rr[r2]; }
                    asm volatile("" : "+v"(rr[4 * rb]), "+v"(rr[4 * rb + 1]), "+v"(rr[4 * rb + 2]), "+v"(rr[4 * rb + 3]) :: "memory");
                }
                v4u o0, o1; o0.x = pk2(rr[0], rr[1]); o0.y = pk2(rr[2], rr[3]); o0.z = pk2(rr[4], rr[5]); o0.w = pk2(rr[6], rr[7]);
                o1.x = pk2(rr[8], rr[9]); o1.y = pk2(rr[10], rr[11]); o1.z = pk2(rr[12], rr[13]); o1.w = pk2(rr[14], rr[15]);
                *(LAS v4u*)(xt + 32 * ib) = o0; *(LAS v4u*)(xt + 32 * ib + 16) = o1;
                LDS_WAIT();
            }
        } else {
            const int tt = tid - 256;
#pragma unroll
            for (int r = 0; r < 4; ++r) { const int chunk = tt + 256 * r, row = chunk >> 4, cch = chunk & 15;
                const v4u qv = *(const LAS v4u*)(lds + QL + row * 272 + cch * 16); const float e = EGf[row];
                v4u o; o.x = pk2(bflo(qv.x) * e, bfhi(qv.x) * e); o.y = pk2(bflo(qv.y) * e, bfhi(qv.y) * e); o.z = pk2(bflo(qv.z) * e, bfhi(qv.z) * e); o.w = pk2(bflo(qv.w) * e, bfhi(qv.w) * e);
                st16_wt(chu + OFF_QG + row * 128 + cch * 8, o); }
            const float Gl = GLf[63];
#pragma unroll
            for (int r = 0; r < 4; ++r) { const int chunk = tt + 256 * r, kk = chunk & 127, cg8 = chunk >> 7;
                float v[8];
#pragma unroll
                for (int e = 0; e < 8; ++e) { const int ci = cg8 * 8 + e; v[e] = bf2f(*(const LAS unsigned short*)(lds + KL + ci * 272 + kk * 2)) * __expf(Gl - GLf[ci]); }
                v4u o; o.x = pk2(v[0], v[1]); o.y = pk2(v[2], v[3]); o.z = pk2(v[4], v[5]); o.w = pk2(v[6], v[7]);
                st16_wt(chu + OFF_KDT + kk * 64 + cg8 * 8, o); }
        }
        BAR_LDS();
#pragma unroll
        for (int r = 0; r < 4; ++r) { const int chunk = tid + 512 * r, mcol = (chunk >> 10) * 128 + (chunk & 15) * 8, row = (chunk & 1023) >> 4;
            unsigned short e8[8];
#pragma unroll
            for (int e = 0; e < 8; ++e) e8[e] = *(const LAS unsigned short*)(lds + XTo + (mcol + e) * 144 + row * 2);
            v4u o; o.x = e8[0] | ((unsigned)e8[1] << 16); o.y = e8[2] | ((unsigned)e8[3] << 16); o.z = e8[4] | ((unsigned)e8[5] << 16); o.w = e8[6] | ((unsigned)e8[7] << 16);
            st16_wt(chu + OFF_U + chunk * 8, o); }
        st16_wt(chu + OFF_ATTN + tid * 8, *(const LAS v4u*)(lds + ATOo + tid * 16));
        asm volatile("s_waitcnt vmcnt(0)" ::: "memory");
        __syncthreads();
        if (tid == 0) __hip_atomic_store(gpflag + uid, 1u, RLX_AGENT_);
    }
}

__device__ __forceinline__ void phase_gs(const Args& a, int j, LAS unsigned char* lds, int tid, int wave, int lane, int bid, int G) {
    constexpr int WL = 0, QGL = 17408, UL = 34816, KDTL = 52224, ATL = 70656, SBL = 79872, VNL = 114688;
    const bf16* ch = (const bf16*)(a.ws + WS_CH); const float* glast = (const float*)(a.ws + WS_GLAST);
    const bf16* proj = (const bf16*)(a.ws + WS_PROJ); bf16* obuf = (bf16*)(a.ws + WS_OBUF);
    const float* nw = a.in[14] + j * 128;
    const int fr = lane & 15, fq = lane >> 4, row8 = tid >> 3, seg = tid & 7;
    constexpr int NWL = 133120;
    if (tid < 128) ((LAS float*)(lds + NWL))[tid] = nw[tid];
    for (int rp = 0; rp < REP_PROMPT; ++rp)
    for (int u = bid; u < 64; u += G) {
        const int b = u >> 3, h = u & 7;
        f32x4 St[8];
#pragma unroll
        for (int kt = 0; kt < 8; ++kt) St[kt] = (f32x4){0.f, 0.f, 0.f, 0.f};
        v4u pu[2], pw[2], pq[2], pk[2], pa, zc[2]; float gl_next, gl_cur;
#define GS_LOAD(nn) do { const bf16* cu = ch + (size_t)(u * 32 + (nn)) * CHU; \
            _Pragma("unroll") for (int r = 0; r < 2; ++r) { const int chunk = tid + 512 * r; pu[r] = *(const v4u*)(cu + OFF_U + chunk * 8); pw[r] = *(const v4u*)(cu + OFF_W + chunk * 8); \
                pq[r] = *(const v4u*)(cu + OFF_QG + chunk * 8); pk[r] = *(const v4u*)(cu + OFF_KDT + chunk * 8); } \
            pa = *(const v4u*)(cu + OFF_ATTN + tid * 8); \
            gl_next = glast[u * 32 + (nn)]; } while (0)
#define GS_STORE() do { \
            _Pragma("unroll") for (int r = 0; r < 2; ++r) { const int chunk = tid + 512 * r, row = chunk >> 4, cch = chunk & 15; \
                *(LAS v4u*)(lds + UL + row * 272 + cch * 16) = pu[r]; *(LAS v4u*)(lds + WL + row * 272 + cch * 16) = pw[r]; *(LAS v4u*)(lds + QGL + row * 272 + cch * 16) = pq[r]; \
                const int rowk = chunk >> 3, cck = chunk & 7; *(LAS v4u*)(lds + KDTL + rowk * 144 + cck * 16) = pk[r]; } \
            *(LAS v4u*)(lds + ATL + row8 * 144 + seg * 16) = pa; gl_cur = gl_next; } while (0)
        unsigned* flg = (unsigned*)(a.ws + WS_BAR + 16384) + j * 2048 + u * 32;
        if (wave == 0) { wait_flag_set(flg + 0, 0u); wait_flag_set(flg + 1, 0u); __builtin_amdgcn_fence(__ATOMIC_ACQUIRE, "agent"); asm volatile("s_waitcnt vmcnt(0)" ::: "memory"); }
        BAR_LDS();
        GS_LOAD(0);
        GS_STORE();
        for (int n = 0; n < 32; ++n) {
            unsigned fnext = 1u;
            if (wave == 0 && n + 2 < 32) fnext = __hip_atomic_load(flg + n + 2, RLX_AGENT_);
            { const bf16* zp = proj + (size_t)(b * SEQ + n * 64 + row8) * GINP + 3072 + h * 128 + seg * 16; zc[0] = *(const v4u*)zp; zc[1] = *(const v4u*)(zp + 8); }
            GS_LOAD(n + 1 < 32 ? n + 1 : 31);
#pragma unroll
            for (int kt = 0; kt < 8; ++kt) { v2u w2; w2.x = pk2(St[kt][0], St[kt][1]); w2.y = pk2(St[kt][2], St[kt][3]);
                *(LAS v2u*)(lds + SBL + (16 * wave + fr) * 272 + (kt * 16 + fq * 4) * 2) = w2; }
            BAR_LDS();
            bf16x8 bS[4];
#pragma unroll
            for (int kk = 0; kk < 4; ++kk) bS[kk] = *(const LAS bf16x8*)(lds + SBL + (16 * wave + fr) * 272 + (kk * 32 + fq * 8) * 2);
            f32x4 accQ[4];
#pragma unroll
            for (int ct = 0; ct < 4; ++ct) {
                f32x4 aw = {0.f, 0.f, 0.f, 0.f}, aq = {0.f, 0.f, 0.f, 0.f};
#pragma unroll
                for (int kk = 0; kk < 4; ++kk) { const bf16x8 fa = *(const LAS bf16x8*)(lds + WL + (ct * 16 + fr) * 272 + (kk * 32 + fq * 8) * 2); aw = MFMA16(fa, bS[kk], aw);
                    const bf16x8 fb = *(const LAS bf16x8*)(lds + QGL + (ct * 16 + fr) * 272 + (kk * 32 + fq * 8) * 2); aq = MFMA16(fb, bS[kk], aq); }
                float vn[4];
#pragma unroll
                for (int r = 0; r < 4; ++r) vn[r] = bf2f(*(const LAS unsigned short*)(lds + UL + (ct * 16 + fq * 4 + r) * 272 + (16 * wave + fr) * 2)) - aw[r];
                v2u w2; w2.x = pk2(vn[0], vn[1]); w2.y = pk2(vn[2], vn[3]);
                *(LAS v2u*)(lds + VNL + (16 * wave + fr) * 144 + (ct * 16 + fq * 4) * 2) = w2;
                accQ[ct] = aq;
            }
            LDS_WAIT();
            bf16x8 bV[2];
#pragma unroll
            for (int jj = 0; jj < 2; ++jj) bV[jj] = *(const LAS bf16x8*)(lds + VNL + (16 * wave + fr) * 144 + (jj * 32 + fq * 8) * 2);
#pragma unroll
            for (int ct = 0; ct < 4; ++ct)
#pragma unroll
                for (int jj = 0; jj < 2; ++jj) { const bf16x8 fa = *(const LAS bf16x8*)(lds + ATL + (ct * 16 + fr) * 144 + (jj * 32 + fq * 8) * 2); accQ[ct] = MFMA16(fa, bV[jj], accQ[ct]); }
#pragma unroll
            for (int kt = 0; kt < 8; ++kt) { St[kt] = St[kt] * gl_cur;
#pragma unroll
                for (int jj = 0; jj < 2; ++jj) { const bf16x8 fa = *(const LAS bf16x8*)(lds + KDTL + (kt * 16 + fr) * 144 + (jj * 32 + fq * 8) * 2); St[kt] = MFMA16(fa, bV[jj], St[kt]); } }
#pragma unroll
            for (int ct = 0; ct < 4; ++ct) { v2u w2; w2.x = pk2(accQ[ct][0], accQ[ct][1]); w2.y = pk2(accQ[ct][2], accQ[ct][3]);
                *(LAS v2u*)(lds + VNL + (16 * wave + fr) * 144 + (ct * 16 + fq * 4) * 2) = w2; }
            if (wave == 0 && n + 2 < 32) { wait_flag_set(flg + n + 2, fnext); __builtin_amdgcn_fence(__ATOMIC_ACQUIRE, "agent"); asm volatile("s_waitcnt vmcnt(0)" ::: "memory"); }
            BAR_LDS();
            GS_STORE();
            {   float ov[16]; float ss = 0.f;
#pragma unroll
                for (int e = 0; e < 16; ++e) { ov[e] = bf2f(*(const LAS unsigned short*)(lds + VNL + (seg * 16 + e) * 144 + row8 * 2)); ss += ov[e] * ov[e]; }
                ss += shx<1>(ss, lane); ss += shx<2>(ss, lane); ss += shx<4>(ss, lane);
                const float rstd = rsqrtf(ss * (1.f / 128.f) + EPS);
                v4u o2[2];
#pragma unroll
                for (int q = 0; q < 4; ++q) { const f32x4 wv = *(const LAS f32x4*)(lds + NWL + (seg * 16 + q * 4) * 4);
                    const unsigned z0 = zc[q >> 1][(q & 1) * 2], z1 = zc[q >> 1][(q & 1) * 2 + 1];
                    const float r0 = ov[4 * q] * rstd * wv.x * silu_f(bflo(z0)), r1 = ov[4 * q + 1] * rstd * wv.y * silu_f(bfhi(z0));
                    const float r2 = ov[4 * q + 2] * rstd * wv.z * silu_f(bflo(z1)), r3 = ov[4 * q + 3] * rstd * wv.w * silu_f(bfhi(z1));
                    o2[q >> 1][(q & 1) * 2] = pk2(r0, r1); o2[q >> 1][(q & 1) * 2 + 1] = pk2(r2, r3); }
                bf16* op = obuf + (size_t)(b * SEQ + n * 64 + row8) * 1024 + h * 128 + seg * 16;
                *(v4u*)op = o2[0]; *(v4u*)(op + 8) = o2[1];
            }
        }
        float* so = a.out + O_GSP + ((size_t)(j * 8 + b) * 8 + h) * 16384;
#pragma unroll
        for (int kt = 0; kt < 8; ++kt)
#pragma unroll
            for (int r = 0; r < 4; ++r) so[(kt * 16 + fq * 4 + r) * 128 + 16 * wave + fr] = St[kt][r];
        BAR_LDS();
    }
#undef GS_LOAD
#undef GS_STORE
    {
        int first, stride;
        if (G > 64) { first = bid - 64; stride = G - 64; } else { first = bid; stride = G; }
        const float* S0 = a.in[2] + (size_t)j * NSEQ_S * 8 * 16384;
        const bf16* qkv = (const bf16*)(a.ws + WS_QKV); const float* gb = (const float*)(a.ws + WS_GB);
        LAS float* qS = (LAS float*)lds;
        LAS float* kS = qS + 512; LAS float* vS = qS + 1024;
        LAS float* part = qS + 1536;
        LAS float* oS = part + 2048;
        LAS float* qkS = oS + 512;
        const int vq = tid & 31, kg = tid >> 5;
        if (first >= 0)
        for (int u = first; u < NSEQ_S * 8; u += stride) {
            const int b = u >> 3, h = u & 7; const int m0 = TP + 4 * b;
            f32x4 Sr[8];
            const float* sp = S0 + (size_t)u * 16384;
#pragma unroll
            for (int i = 0; i < 8; ++i) Sr[i] = *(const f32x4*)(sp + (kg * 8 + i) * 128 + vq * 4);
            for (int e = tid; e < 1536; e += 512) { const int tok = e / 384, rem = e - tok * 384, sect = rem >> 7, c = rem & 127;
                qS[sect * 512 + tok * 128 + c] = bf2f(qkv[(size_t)(m0 + tok) * CONVD + sect * 1024 + h * 128 + c]); }
            if (tid < 8) qkS[4 + tid] = gb[(size_t)(m0 + (tid & 3)) * 16 + (tid >> 2) * 8 + h];
            BAR_LDS();
            if (wave < 4) { const float d = qS[wave * 128 + lane] * kS[wave * 128 + lane] + qS[wave * 128 + 64 + lane] * kS[wave * 128 + 64 + lane]; const float s = wave_sum(lane, d); if (lane == 0) qkS[wave] = s; }
            BAR_LDS();
            for (int tok = 0; tok < 4; ++tok) {
                f32x4 pk4 = {0.f, 0.f, 0.f, 0.f}, pq4 = {0.f, 0.f, 0.f, 0.f};
#pragma unroll
                for (int i = 0; i < 8; ++i) { const float kv = kS[tok * 128 + kg * 8 + i], qv = qS[tok * 128 + kg * 8 + i]; pk4 += kv * Sr[i]; pq4 += qv * Sr[i]; }
#pragma unroll
                for (int e = 0; e < 4; ++e) { pk4[e] += shx<32>(pk4[e], lane); pq4[e] += shx<32>(pq4[e], lane); }
                if (lane < 32) { *(LAS f32x4*)(part + wave * 256 + vq * 4) = pk4; *(LAS f32x4*)(part + wave * 256 + 128 + vq * 4) = pq4; }
                BAR_LDS();
                f32x4 kSv = {0.f, 0.f, 0.f, 0.f}, qSv = {0.f, 0.f, 0.f, 0.f};
#pragma unroll
                for (int w = 0; w < 8; ++w) { kSv += *(const LAS f32x4*)(part + w * 256 + vq * 4); qSv += *(const LAS f32x4*)(part + w * 256 + 128 + vq * 4); }
                const float bt = qkS[4 + tok], eg = __expf(qkS[8 + tok]);
                const f32x4 vv = *(const LAS f32x4*)(vS + tok * 128 + vq * 4);
                const f32x4 dv4 = vv - eg * kSv;
                const f32x4 o4 = eg * qSv + (bt * qkS[tok]) * dv4;
#pragma unroll
                for (int i = 0; i < 8; ++i) { const float kv = kS[tok * 128 + kg * 8 + i]; Sr[i] = eg * Sr[i] + (bt * kv) * dv4; }
                if (tid < 32) *(LAS f32x4*)(oS + tok * 128 + vq * 4) = o4;
                BAR_LDS();
            }
            if (tid < 256) { const int tok = wave; const f32x2 o2 = *(const LAS f32x2*)(oS + tok * 128 + 2 * lane);
                const float ss = wave_sum(lane, o2.x * o2.x + o2.y * o2.y); const float rstd = rsqrtf(ss * (1.f / 128.f) + EPS);
                const unsigned zz = *(const unsigned*)(proj + (size_t)(m0 + tok) * GINP + 3072 + h * 128 + 2 * lane);
                const f32x2 wv = *(const f32x2*)(nw + 2 * lane);
                *(unsigned*)(obuf + (size_t)(m0 + tok) * 1024 + h * 128 + 2 * lane) = pk2(o2.x * rstd * wv.x * silu_f(bflo(zz)), o2.y * rstd * wv.y * silu_f(bfhi(zz))); }
            float* so = a.out + O_GSS + ((size_t)j * NSEQ_S * 8 + u) * 16384;
#pragma unroll
            for (int i = 0; i < 8; ++i) *(f32x4*)(so + (kg * 8 + i) * 128 + vq * 4) = Sr[i];
            BAR_LDS();
        }
    }
}

__device__ __forceinline__ void phase_ss(const Args& a, int j, LAS unsigned char* lds, int tid, int wave, int lane, int bid, int G) {
    constexpr int CL = 0, BLo = 17408, BTL = 34816, XSL = 53248, XDT = 62464, XWT = 71680, LLo = 80896, HBL = 90112, YL = 107520, ACL = 124928;
    const bf16* xbc = (const bf16*)(a.ws + WS_QKV); const float* dtb = (const float*)(a.ws + WS_GB);
    const bf16* proj = (const bf16*)(a.ws + WS_PROJ); bf16* obuf = (bf16*)(a.ws + WS_OBUF); float* ssq = (float*)(a.ws + WS_SSQ);
    const float* Alog = a.in[20] + j * 32; const float* Dsk = a.in[21] + j * 32;
    const int fr = lane & 15, fq = lane >> 4, row8 = tid >> 3, seg = tid & 7;
    LAS float* ACf = (LAS float*)(lds + ACL); LAS float* YLf = (LAS float*)(lds + YL);
    const int ptile = wave & 3, sg = wave >> 2;
    const float* H0 = a.in[4] + (size_t)j * NSEQ_S * 32 * 8192;
    LAS float* xsS = (LAS float*)(lds + 125440);
    LAS float* BS = xsS + 256;
    LAS float* CS = BS + 512;
    LAS float* yS = CS + 512;
    const int sq = tid & 7, pg = tid >> 3;
    f32x4 Hn[4]; unsigned short sgv[3]; float sdt[4]; unsigned short sz;
#define SSS_PREF(uu) do { const int u_ = (uu); const int b_ = u_ >> 5, h_ = u_ & 31, g_ = h_ >> 3; const int mm = TP + 4 * b_; \
        const float* hp = H0 + (size_t)u_ * 8192; \
        _Pragma("unroll") for (int i = 0; i < 4; ++i) Hn[i] = *(const f32x4*)(hp + pg * 128 + 16 * sq + 4 * i); \
        _Pragma("unroll") for (int k = 0; k < 3; ++k) { { const int e0 = tid + 512 * k; const int e = e0 < 1280 ? e0 : 1279; const int tok = e / 320, rem = e - tok * 320; \
            const int col = rem < 64 ? h_ * 64 + rem : (rem < 192 ? 2048 + g_ * 128 + rem - 64 : 2560 + g_ * 128 + rem - 192); sgv[k] = xbc[(size_t)(mm + tok) * CONVD + col]; } } \
        _Pragma("unroll") for (int k = 0; k < 4; ++k) sdt[k] = dtb[(size_t)(mm + k) * 32 + h_]; \
        sz = proj[(size_t)(mm + (tid >> 6 & 3)) * SINP + h_ * 64 + (tid & 63)]; } while (0)
    const bool inter = (G == 256);
    int su = bid;
    if (su < NSEQ_S * 32) SSS_PREF(su);
    for (int rp = 0; rp < REP_PROMPT; ++rp)
    for (int u0 = bid; u0 < 256; u0 += G) {
        int u = u0;
        if (G == 256) { const int x = u0 & 7, sl = u0 >> 3, pgi = x + 8 * (sl >> 3); u = (pgi >> 2) * 32 + (pgi & 3) * 8 + (sl & 7); }
        const int b = u >> 5, h = u & 31, g = h >> 3; const float Ah = -__expf(Alog[h]); const float Dh = Dsk[h];
        f32x4 Hs[4];
#pragma unroll
        for (int q = 0; q < 4; ++q) Hs[q] = (f32x4){0.f, 0.f, 0.f, 0.f};
        v4u px, pB[2], pC[2], zc; float pdt;
#define SS_LOAD(nn) do { const int m0_ = b * SEQ + (nn) * 64; \
            px = *(const v4u*)(xbc + (size_t)(m0_ + row8) * CONVD + h * 64 + seg * 8); \
            _Pragma("unroll") for (int r = 0; r < 2; ++r) { const int chunk = tid + 512 * r, row = chunk >> 4, cch = chunk & 15; \
                pB[r] = *(const v4u*)(xbc + (size_t)(m0_ + row) * CONVD + 2048 + g * 128 + cch * 8); pC[r] = *(const v4u*)(xbc + (size_t)(m0_ + row) * CONVD + 2560 + g * 128 + cch * 8); } \
            pdt = dtb[(size_t)(m0_ + lane) * 32 + h]; } while (0)
#define SS_FILL() do { const float Ac = wave_incl_scan(pdt * Ah, lane); const float Ac_r = shi(Ac, row8), dt_r = shi(pdt, row8), last_ = shi(Ac, 63); \
            if (wave == 0) ACf[lane] = Ac; \
            _Pragma("unroll") for (int r = 0; r < 2; ++r) { const int chunk = tid + 512 * r, row = chunk >> 4, cch = chunk & 15; \
                *(LAS v4u*)(lds + BLo + row * 272 + cch * 16) = pB[r]; *(LAS v4u*)(lds + CL + row * 272 + cch * 16) = pC[r]; \
                _Pragma("unroll") for (int e = 0; e < 4; ++e) { const unsigned wv = pB[r][e]; \
                    *(LAS unsigned short*)(lds + BTL + tsw_w(cch * 8 + 2 * e, row)) = (unsigned short)(wv & 0xffffu); \
                    *(LAS unsigned short*)(lds + BTL + tsw_w(cch * 8 + 2 * e + 1, row)) = (unsigned short)(wv >> 16); } } \
            *(LAS v4u*)(lds + XSL + row8 * 144 + seg * 16) = px; \
            const float wt_ = dt_r * __expf(last_ - Ac_r); \
            _Pragma("unroll") for (int e = 0; e < 4; ++e) { const float x0 = bflo(px[e]), x1 = bfhi(px[e]); \
                *(LAS unsigned short*)(lds + XDT + tsw_w(seg * 8 + 2 * e, row8)) = f2bf(x0 * dt_r); *(LAS unsigned short*)(lds + XDT + tsw_w(seg * 8 + 2 * e + 1, row8)) = f2bf(x1 * dt_r); \
                *(LAS unsigned short*)(lds + XWT + tsw_w(seg * 8 + 2 * e, row8)) = f2bf(x0 * wt_); *(LAS unsigned short*)(lds + XWT + tsw_w(seg * 8 + 2 * e + 1, row8)) = f2bf(x1 * wt_); } \
            } while (0)
        SS_LOAD(0);
        SS_FILL();
        for (int n = 0; n < 32; ++n) {
            const int m0 = b * SEQ + n * 64;
            zc = *(const v4u*)(proj + (size_t)(m0 + row8) * SINP + h * 64 + seg * 8);
            SS_LOAD(n + 1 < 32 ? n + 1 : 31);
            const bool sstep = inter && ((n & 1) == 0) && su < NSEQ_S * 32;
            const int sb_ = su >> 5, sh_ = su & 31; const int sm0 = TP + 4 * sb_;
            if (sstep) {
#pragma unroll
                for (int k = 0; k < 3; ++k) { const int e = tid + 512 * k; if (e < 1280) { const int tok = e / 320, rem = e - tok * 320; const float v = bf2f(sgv[k]);
                    if (rem < 64) xsS[tok * 64 + rem] = v; else if (rem < 192) BS[tok * 128 + rem - 64] = v; else CS[tok * 128 + rem - 192] = v; } }
            }
#pragma unroll
            for (int q = 0; q < 4; ++q) { const int stile = 4 * sg + q; v2u w2; w2.x = pk2(Hs[q][0], Hs[q][1]); w2.y = pk2(Hs[q][2], Hs[q][3]);
                *(LAS v2u*)(lds + HBL + (16 * ptile + fr) * 272 + (stile * 16 + fq * 4) * 2) = w2; }
            BAR_LDS();
            if (sstep) {
                const float sAh = -__expf(Alog[sh_]);
#pragma unroll
                for (int tok = 0; tok < 4; ++tok) {
                    const float dt = sdt[tok]; const float dA = __expf(dt * sAh);
                    const float dx = dt * xsS[tok * 64 + pg]; float y = 0.f;
#pragma unroll
                    for (int i = 0; i < 4; ++i) { const f32x4 B4 = *(const LAS f32x4*)(BS + tok * 128 + 16 * sq + 4 * i), C4 = *(const LAS f32x4*)(CS + tok * 128 + 16 * sq + 4 * i);
                        Hn[i] = dA * Hn[i] + dx * B4; y += (Hn[i].x * C4.x + Hn[i].y * C4.y) + (Hn[i].z * C4.z + Hn[i].w * C4.w); }
                    y += shx<1>(y, lane); y += shx<2>(y, lane); y += shx<4>(y, lane);
                    if (sq == 0) yS[tok * 64 + pg] = y;
                }
            }
#pragma unroll
            for (int tt = 0; tt < 2; ++tt) { const int id = 2 * wave + tt, tr = id >> 2, tc = id & 3; const int jcol = tc * 16 + fr;
                if (tc <= tr) {
                    f32x4 acc = {0.f, 0.f, 0.f, 0.f};
#pragma unroll
                    for (int kk = 0; kk < 4; ++kk) { const bf16x8 fa = *(const LAS bf16x8*)(lds + CL + (tr * 16 + fr) * 272 + (kk * 32 + fq * 8) * 2);
                        const bf16x8 fb = *(const LAS bf16x8*)(lds + BLo + (tc * 16 + fr) * 272 + (kk * 32 + fq * 8) * 2); acc = MFMA16(fa, fb, acc); }
                    const float Aj = ACf[jcol];
#pragma unroll
                    for (int r = 0; r < 4; ++r) { const int i = tr * 16 + fq * 4 + r; const float val = (i >= jcol) ? acc[r] * __expf(ACf[i] - Aj) : 0.f;
                        *(LAS unsigned short*)(lds + LLo + i * 144 + jcol * 2) = f2bf(val); }
                } else {
#pragma unroll
                    for (int r = 0; r < 4; ++r) { const int i = tr * 16 + fq * 4 + r; *(LAS unsigned short*)(lds + LLo + i * 144 + jcol * 2) = 0; }
                }
            }
            BAR_LDS();
            if (sstep) {
                if (tid < 256) { const int tok = wave, p = lane;
                    const float val = (yS[tok * 64 + p] + Dsk[sh_] * xsS[tok * 64 + p]) * silu_f(bf2f(sz));
                    const float ss = wave_sum(lane, val * val); if (lane == 0) ssq[(size_t)(sm0 + tok) * 32 + sh_] = ss;
                    obuf[(size_t)(sm0 + tok) * 2048 + sh_ * 64 + p] = f2bf(val); }
                float* sho = a.out + O_SHS + ((size_t)j * NSEQ_S * 32 + su) * 8192;
#pragma unroll
                for (int i = 0; i < 4; ++i) *(f32x4*)(sho + pg * 128 + 16 * sq + 4 * i) = Hn[i];
                su += G;
                SSS_PREF(su < NSEQ_S * 32 ? su : su - G);
            }
            const float last = ACf[63];
#pragma unroll
            for (int tt = 0; tt < 2; ++tt) { const int it = 2 * sg + tt;
                f32x4 acc = {0.f, 0.f, 0.f, 0.f};
#pragma unroll
                for (int kk = 0; kk < 4; ++kk) { const bf16x8 fa = *(const LAS bf16x8*)(lds + CL + (it * 16 + fr) * 272 + (kk * 32 + fq * 8) * 2);
                    const bf16x8 fb = *(const LAS bf16x8*)(lds + HBL + (16 * ptile + fr) * 272 + (kk * 32 + fq * 8) * 2); acc = MFMA16(fa, fb, acc); }
#pragma unroll
                for (int r = 0; r < 4; ++r) acc[r] *= __expf(ACf[it * 16 + fq * 4 + r]);
#pragma unroll
                for (int jj = 0; jj < 2; ++jj) { const bf16x8 fa = *(const LAS bf16x8*)(lds + LLo + (it * 16 + fr) * 144 + (jj * 32 + fq * 8) * 2);
                    const bf16x8 fb = *(const LAS bf16x8*)(lds + XDT + tsw_r(16 * ptile + fr, jj * 4 + fq)); acc = MFMA16(fa, fb, acc); }
#pragma unroll
                for (int r = 0; r < 4; ++r) YLf[(it * 16 + fq * 4 + r) * 68 + 16 * ptile + fr] = acc[r];
            }
            {   const float eL = __expf(last);
                bf16x8 bX[2];
#pragma unroll
                for (int jj = 0; jj < 2; ++jj) bX[jj] = *(const LAS bf16x8*)(lds + XWT + tsw_r(16 * ptile + fr, jj * 4 + fq));
#pragma unroll
                for (int q = 0; q < 4; ++q) { const int stile = 4 * sg + q; Hs[q] = Hs[q] * eL;
#pragma unroll
                    for (int jj = 0; jj < 2; ++jj) { const bf16x8 fa = *(const LAS bf16x8*)(lds + BTL + tsw_r(stile * 16 + fr, jj * 4 + fq)); Hs[q] = MFMA16(fa, bX[jj], Hs[q]); } }
            }
            BAR_LDS();
            {   const f32x4 y0 = *(const LAS f32x4*)(lds + YL + (row8 * 68 + seg * 8) * 4), y1 = *(const LAS f32x4*)(lds + YL + (row8 * 68 + seg * 8 + 4) * 4);
                const v4u xv = *(const LAS v4u*)(lds + XSL + row8 * 144 + seg * 16);
                float val[8]; float ss = 0.f;
#pragma unroll
                for (int e = 0; e < 4; ++e) { const float ya = e < 2 ? y0[2 * e] : y1[2 * e - 4], yb = e < 2 ? y0[2 * e + 1] : y1[2 * e - 3];
                    val[2 * e] = (ya + Dh * bflo(xv[e])) * silu_f(bflo(zc[e])); val[2 * e + 1] = (yb + Dh * bfhi(xv[e])) * silu_f(bfhi(zc[e]));
                    ss += val[2 * e] * val[2 * e] + val[2 * e + 1] * val[2 * e + 1]; }
                ss += shx<1>(ss, lane); ss += shx<2>(ss, lane); ss += shx<4>(ss, lane);
                if (seg == 0) ssq[(size_t)(m0 + row8) * 32 + h] = ss;
                v4u o; o.x = pk2(val[0], val[1]); o.y = pk2(val[2], val[3]); o.z = pk2(val[4], val[5]); o.w = pk2(val[6], val[7]);
                *(v4u*)(obuf + (size_t)(m0 + row8) * 2048 + h * 64 + seg * 8) = o;
            }
            BAR_LDS();
            SS_FILL();
        }
        float* ho = a.out + O_SHP + ((size_t)(j * 8 + b) * 32 + h) * 8192;
#pragma unroll
        for (int q = 0; q < 4; ++q) { const int stile = 4 * sg + q; *(f32x4*)(ho + (16 * ptile + fr) * 128 + stile * 16 + fq * 4) = Hs[q]; }
        BAR_LDS();
    }
#undef SS_LOAD
#undef SS_FILL
    {
        for (int u = su; u < NSEQ_S * 32; u += G) {
            const int b = u >> 5, h = u & 31; const int m0 = TP + 4 * b;
            const float Ah = -__expf(Alog[h]); const float Dh = Dsk[h];
            f32x4 Hr[4]; float dtc[4];
#pragma unroll
            for (int i = 0; i < 4; ++i) Hr[i] = Hn[i];
#pragma unroll
            for (int k = 0; k < 4; ++k) dtc[k] = sdt[k];
            const float zz = bf2f(sz);
#pragma unroll
            for (int k = 0; k < 3; ++k) { const int e = tid + 512 * k; if (e < 1280) { const int tok = e / 320, rem = e - tok * 320; const float v = bf2f(sgv[k]);
                if (rem < 64) xsS[tok * 64 + rem] = v; else if (rem < 192) BS[tok * 128 + rem - 64] = v; else CS[tok * 128 + rem - 192] = v; } }
            BAR_LDS();
            SSS_PREF(u + G < NSEQ_S * 32 ? u + G : u);
#pragma unroll
            for (int tok = 0; tok < 4; ++tok) {
                const float dt = dtc[tok]; const float dA = __expf(dt * Ah);
                const float dx = dt * xsS[tok * 64 + pg]; float y = 0.f;
#pragma unroll
                for (int i = 0; i < 4; ++i) { const f32x4 B4 = *(const LAS f32x4*)(BS + tok * 128 + 16 * sq + 4 * i), C4 = *(const LAS f32x4*)(CS + tok * 128 + 16 * sq + 4 * i);
                    Hr[i] = dA * Hr[i] + dx * B4; y += (Hr[i].x * C4.x + Hr[i].y * C4.y) + (Hr[i].z * C4.z + Hr[i].w * C4.w); }
                y += shx<1>(y, lane); y += shx<2>(y, lane); y += shx<4>(y, lane);
                if (sq == 0) yS[tok * 64 + pg] = y;
            }
            BAR_LDS();
            if (tid < 256) { const int tok = wave, p = lane;
                const float val = (yS[tok * 64 + p] + Dh * xsS[tok * 64 + p]) * silu_f(zz);
                const float ss = wave_sum(lane, val * val); if (lane == 0) ssq[(size_t)(m0 + tok) * 32 + h] = ss;
                obuf[(size_t)(m0 + tok) * 2048 + h * 64 + p] = f2bf(val); }
            float* ho = a.out + O_SHS + ((size_t)j * NSEQ_S * 32 + u) * 8192;
#pragma unroll
            for (int i = 0; i < 4; ++i) *(f32x4*)(ho + pg * 128 + 16 * sq + 4 * i) = Hr[i];
            BAR_LDS();
        }
#undef SSS_PREF
    }
}

constexpr int NSUB = 11, N_PHASES = 1 + 4 * NSUB;
#ifndef REP_SUBMASK
#define REP_LMASK 15
#define REP_SUBMASK 0
#endif
__host__ __device__ __forceinline__ bool phase_is_noop(int ph) { if (ph == 0) return false; const int L = (ph - 1) / NSUB, sub = (ph - 1) % NSUB; (void)L; return sub == 2 || sub == 6 || sub == 10; }

__global__ void __launch_bounds__(512, 2) fwd_kernel(Args a) {
    extern __shared__ __attribute__((aligned(16))) unsigned char lds_raw[];
    LAS unsigned char* lds = (LAS unsigned char*)lds_raw;
    cg::grid_group grid = cg::this_grid();
    if (a.ph_lo < 0) grid.sync();
    volatile LAS unsigned* bst = (volatile LAS unsigned*)(lds + LDS_BYTES - 16);
    if (threadIdx.x == 0) { bst[0] = 0u; bst[1] = 0u; }
    __syncthreads();
    const XcdBarrier gbar = xcd_barrier_post((unsigned*)(a.ws + WS_BAR), bst);
    for (int ph = a.ph_lo; ph < a.ph_hi; ++ph) {
        if (phase_is_noop(ph)) continue;
        int reps = 1;
        if (ph == 0) { if (REP_SUBMASK & 2048) reps = 2; } else if (((REP_SUBMASK >> ((ph - 1) % NSUB)) & 1) && ((REP_LMASK >> ((ph - 1) / NSUB)) & 1)) reps = 2;
        for (int rep = 0; rep < reps; ++rep) {
        int tid = threadIdx.x; asm volatile("" : "+v"(tid));
        int G = gridDim.x, bid = blockIdx.x; asm volatile("" : "+s"(G), "+s"(bid));
        const int lane = tid & 63, wave = __builtin_amdgcn_readfirstlane(tid >> 6);
        unsigned char* ws = a.ws; asm volatile("" : "+s"(ws));
        int cv_lo = 0, cv_hi = 0, cw_id = 0, cw_n = 1;
        if (ph == 0) { phase_prologue(a, lds, wave, lane, bid, G); cv_hi = CV_N0; cw_id = bid * 8 + wave; cw_n = G * 8; }
        else {
            const int L = (ph - 1) / NSUB, sub = (ph - 1) % NSUB, j = L >> 1; const bool isG = (L & 1) == 0;
            bool do_gemm = false, do_res = false;
            const bf16* gA = nullptr; const bf16* gB = nullptr; bf16* gO = nullptr; int gM = 0, gN = 0, gK = 0, gLD = 0, gC = bid;
            const bf16* r_g2 = nullptr;
            int r_lo = 0, r_hi = 0, r_gw = 0, r_ngw = 1; bool r_ffn = false;
            constexpr int NSB = 32;
            bf16* const gpart1 = (bf16*)(ws + WS_GOUT + 40 * MiB);
            bool g_wt = false; int r_np = 0;
            if (sub == 0) { do_gemm = true; gA = (const bf16*)(ws + WS_HN); gM = T; gK = DM; gLD = DM; gO = (bf16*)(ws + WS_PROJ);
                if (isG) { gN = GINP; gB = (const bf16*)(ws + WS_WGIN) + (size_t)j * GINP * DM; } else { gN = SINP; gB = (const bf16*)(ws + WS_WSIN) + (size_t)j * SINP * DM; } }
            else if (sub == 4 || sub == 5 || sub == 8 || sub == 9) {
                const bool dn = sub >= 8; const bool second = (sub == 5 || sub == 9);
                if (!second || bid < NSB) {
                    do_gemm = true; gN = DM;
                    if (!dn) { gA = (const bf16*)(ws + WS_OBUF); gK = isG ? 1024 : 2048; gB = isG ? (const bf16*)(ws + WS_WGOUT) + (size_t)j * DM * DM : (const bf16*)(ws + WS_WSOUT) + (size_t)j * DM * 2048; }
                    else { gA = (const bf16*)(ws + WS_ACT); gK = DFF; gB = (const bf16*)(ws + WS_WDN) + (size_t)L * DM * DFF; }
                    gO = (bf16*)(ws + WS_GOUT); gM = TP;
                    gLD = gK;
                    if (second) { gA += (size_t)TP * gK; gO += (size_t)TP * DM; gM = T - TP;
                        const int ks = bid >> 3, n128 = gK >> 7, k0 = ((ks * n128) >> 2) << 7, k1 = (((ks + 1) * n128) >> 2) << 7;
                        gC = bid & 7; gK = k1 - k0; gA += k0; gB += k0; if (ks) gO = gpart1 + (size_t)(ks - 1) * (T - TP) * DM; g_wt = true; }
                }
            }
            if (do_gemm) {
                pg8::Gemm g{gA, gB, gM, gN, gK, gLD};
                pg8::StaticOrder S; S.init(gM, gN, G, gC);
                pg8::EpiBf16 E{gO, gN, g_wt};
                pg8::gemm_phase<pg8::EpiBf16, pg8::StaticOrder, true, true>(lds, g, S, E);
            }
            if ((sub == 5 || sub == 9) && bid < NSB) {
                asm volatile("s_waitcnt vmcnt(0)" ::: "memory"); __syncthreads();
                if (tid == 0) { unsigned* cnt = (unsigned*)(ws + WS_BAR + 32768) + (L * 2 + (sub == 9 ? 1 : 0)) * 64;
                    __hip_atomic_fetch_add(cnt, 1u, RLX_AGENT_);
                    unsigned spins = 0; while (__hip_atomic_load(cnt, RLX_AGENT_) < (unsigned)NSB && spins < (1u << 22)) { __builtin_amdgcn_s_sleep(2); ++spins; }
                    __builtin_amdgcn_fence(__ATOMIC_ACQUIRE, "agent"); asm volatile("s_waitcnt vmcnt(0)" ::: "memory"); }
                __syncthreads();
            }
            if (sub == 5 || sub == 9) {
                do_res = true; r_ffn = sub == 9;
                if (bid >= NSB) { r_lo = 0; r_hi = TP; r_gw = (bid - NSB) * 8 + wave; r_ngw = (G - NSB) * 8; }
                else { r_lo = TP; r_hi = T; r_gw = bid * 8 + wave; r_ngw = NSB * 8; r_g2 = gpart1 - (size_t)TP * DM; r_np = 3; }
            }
            if (do_res) phase_res(a, L, r_ffn, r_lo, r_hi, r_gw, r_ngw, lane, r_g2, r_np);
            if (sub == 1) { if (isG) phase_conv<true>(a, j, wave, lane, bid, G); else phase_conv<false>(a, j, wave, lane, bid, G); }
            else if (sub == 3) { if (isG) { if (bid >= 64) phase_gp(a, j, lds, tid, wave, lane, bid, G); phase_gs(a, j, lds, tid, wave, lane, bid, G); } else phase_ss(a, j, lds, tid, wave, lane, bid, G); }
            else if (sub == 7) {
                pg8::Gemm g{(const bf16*)(ws + WS_HN), (const bf16*)(ws + WS_WGU) + (size_t)L * 2 * DFF * DM, T, 2 * DFF, DM, DM};
                pg8::StaticOrder S; S.init(T, 2 * DFF, G, bid);
                pg8::EpiSwiGLU E{(bf16*)(ws + WS_ACT), DFF};
                pg8::gemm_phase<pg8::EpiSwiGLU, pg8::StaticOrder, true, true>(lds, g, S, E);
            }
        }
        if (ph > 0) { const int sub_ = (ph - 1) % NSUB, L_ = (ph - 1) / NSUB;
            if (sub_ == 0 || sub_ == 7) {
                const int nN = sub_ == 7 ? (2 * DFF) / 256 : ((L_ & 1) ? SINP / 256 : GINP / 256); const int nwg = (T / 256) * nN, rounds = (nwg + G - 1) / G, c0 = nwg - (rounds - 1) * G, w = 2 * L_ + (sub_ == 7 ? 1 : 0);
                if (bid >= c0 && c0 < G) { cv_lo = CV_N0 + CV_WB(w); cv_hi = CV_N0 + CV_WB(w + 1); cw_id = (bid - c0) * 8 + wave; cw_n = (G - c0) * 8; } } }
        if (cv_hi > cv_lo) phase_convert(a, lds, cv_lo, cv_hi, cw_id, cw_n, wave, lane);
        }
        if (ph + 1 < a.ph_hi) { xcd_barrier(gbar); if (REP_BARRIER) xcd_barrier(gbar); }
    }
}

#ifndef MK_MULTI
#define MK_MULTI 0
#endif
extern "C" void kernel_launch(void* const* d_in, const int* in_sizes, int n_in, void* d_out, int out_size, void* d_ws, size_t ws_size, hipStream_t stream) {
    static int grid = 0;
    if (grid == 0) {
        if (n_in != 27 || (size_t)out_size != O_END || ws_size < WS_END) { fprintf(stderr, "kernel_launch: unexpected shapes n_in %d out %d ws %zu\n", n_in, out_size, ws_size); grid = -1; return; }
        int dev = 0, cus = 0, per_cu = 0;
        hipGetDevice(&dev); hipDeviceGetAttribute(&cus, hipDeviceAttributeMultiprocessorCount, dev);
        if (hipFuncSetAttribute((const void*)fwd_kernel, hipFuncAttributeMaxDynamicSharedMemorySize, LDS_BYTES) != hipSuccess) { fprintf(stderr, "kernel_launch: hipFuncSetAttribute failed\n"); grid = -1; return; }
        if (hipOccupancyMaxActiveBlocksPerMultiprocessor(&per_cu, (const void*)fwd_kernel, 512, LDS_BYTES) != hipSuccess || per_cu < 1) { fprintf(stderr, "kernel_launch: occupancy query gave %d\n", per_cu); per_cu = 1; }
        (void)hipGetLastError();
        grid = cus * (per_cu > 1 ? 1 : per_cu);
        if (grid <= 0) grid = 256;
        if (grid <= 64) { fprintf(stderr, "kernel_launch: this kernel needs more than 64 resident workgroups (got %d)\n", grid); grid = -1; return; }
    }
    if (grid < 0) return;
    if (hipMemsetAsync((char*)d_ws + WS_BAR, 0, 36864, stream) != hipSuccess) { fprintf(stderr, "kernel_launch: memset of barrier words failed\n"); return; }
    Args a{};
    for (int i = 0; i < 27; ++i) a.in[i] = (const float*)d_in[i];
    a.out = (float*)d_out; a.ws = (unsigned char*)d_ws;
#if MK_MULTI
    for (int ph = 0; ph < N_PHASES; ++ph) {
        if (phase_is_noop(ph)) continue;
        a.ph_lo = ph; a.ph_hi = ph + 1;
        void* args[] = {&a};
        hipError_t e = hipLaunchCooperativeKernel((const void*)fwd_kernel, dim3(grid), dim3(512), args, LDS_BYTES, stream);
        if (e != hipSuccess) { fprintf(stderr, "cooperative launch failed (phase %d): %s (grid %d)\n", ph, hipGetErrorString(e), grid); break; }
    }
#else
    a.ph_lo = 0; a.ph_hi = N_PHASES;
    void* args[] = {&a};
    hipError_t e = hipLaunchCooperativeKernel((const void*)fwd_kernel, dim3(grid), dim3(512), args, LDS_BYTES, stream);
    if (e != hipSuccess) fprintf(stderr, "cooperative launch failed: %s (grid %d)\n", hipGetErrorString(e), grid);
#endif
}
```

```cpp
#include <hip/hip_runtime.h>
#include <hip/hip_cooperative_groups.h>
#include <cstdio>
#include <cstdint>
namespace cg = cooperative_groups;
namespace pg8 {
#define PG8_LAS __attribute__((address_space(3)))
typedef unsigned short bf16_t;
typedef short bf16x8 __attribute__((ext_vector_type(8)));
typedef float f32x4 __attribute__((ext_vector_type(4)));
typedef unsigned u32x4 __attribute__((ext_vector_type(4)));
constexpr int BM = 256, BK = 64, HALF = 128, HTB = HALF * BK * 2  , STAGE_BYTES = 8 * HTB, NXCD = 8, WGM = 8;

__host__ __device__ __forceinline__ int lds_byte(int r, int c) { const int st = (r >> 4) * 2 + (c >> 5), rr = r & 15, cc = c & 31, ob = rr * 64 + cc * 2; return st * 1024 + (ob ^ (((ob >> 9) & 1) << 5)); }
__host__ __device__ __forceinline__ void stage_rc(int b, int& R, int& C) { const int st = b / 1024, sb = b % 1024, swz = sb ^ (((sb >> 9) & 1) << 5); R = (st >> 1) * 16 + swz / 64; C = (st & 1) * 32 + (swz % 64) / 2; }
__host__ __device__ __forceinline__ int perm32(int rho) { const int n = rho >> 4, i = rho & 15; return 8 * (i >> 2) + 4 * n + (i & 3); }

struct Unit { int pm, pn; };
struct Gemm { const bf16_t* A; const bf16_t* Bt; int M, N, K, ld; };

struct StaticOrder {
    int nM, nN, nwg, G, c;
    __host__ __device__ void init(int M, int N, int G_, int c_) { nM = M / BM; nN = N / BM; nwg = nM * nN; G = G_; c = c_; }
    __host__ __device__ bool next(int i, Unit& u) const {
        const long L = (long)i * G + c; if (L >= nwg) return false;
        int wgid = (int)L; { const int q = nwg / NXCD, r = nwg % NXCD, xcd = wgid % NXCD, off = wgid / NXCD; wgid = (xcd < r ? xcd * (q + 1) : r * (q + 1) + (xcd - r) * q) + off; }
        const int nig = WGM * nN, gid = wgid / nig, fm = gid * WGM, gsz = (nM - fm) < WGM ? (nM - fm) : WGM;
        u.pm = fm + ((wgid % nig) % gsz); u.pn = (wgid % nig) / gsz; return true;
    }
    __device__ __forceinline__ void a_ready(const Unit&) const {}
    __device__ __forceinline__ void done(const Unit&) const {}
};

__device__ __forceinline__ unsigned cvt_pk_bf16(float lo, float hi) { unsigned r; asm volatile("v_cvt_pk_bf16_f32 %0, %1, %2" : "=v"(r) : "v"(lo), "v"(hi)); return r; }
__device__ __forceinline__ float silu_f(float x) { return x * __builtin_amdgcn_rcpf(1.0f + __expf(-x)); }
struct EpiBf16 {
    static constexpr bool PERM = true, AFTER_DRAIN = false;
    bf16_t* O; int ldc; bool wt;
    __device__ __forceinline__ void operator()(const f32x4 (&acc)[2][2][4][2], const Unit& u, int wr, int wc, int fr, int fq) const {
        const int row0 = u.pm * BM + wr * 64 + fr; const int col0 = u.pn * BM + wc * 32 + 8 * fq;
#pragma unroll
        for (int ai = 0; ai < 2; ++ai)
#pragma unroll
            for (int m = 0; m < 4; ++m) { bf16_t* rowp = O + (size_t)(row0 + ai * HALF + m * 16) * ldc + col0;
#pragma unroll
                for (int bj = 0; bj < 2; ++bj) { const f32x4 v0 = acc[ai][bj][m][0], v1 = acc[ai][bj][m][1];
                    u32x4 w; w.x = cvt_pk_bf16(v0[0], v0[1]); w.y = cvt_pk_bf16(v0[2], v0[3]); w.z = cvt_pk_bf16(v1[0], v1[1]); w.w = cvt_pk_bf16(v1[2], v1[3]);
                    if (wt) asm volatile("global_store_dwordx4 %0, %1, off sc1\n\ts_nop 1" :: "v"(rowp + bj * HALF), "v"(w) : "memory");
                    else *(u32x4*)(rowp + bj * HALF) = w; } }
    }
};
struct EpiSwiGLU {
    static constexpr bool PERM = true, AFTER_DRAIN = false;
    bf16_t* O; int ldc;
    __device__ __forceinline__ void operator()(const f32x4 (&acc)[2][2][4][2], const Unit& u, int wr, int wc, int fr, int fq) const {
        const int row0 = u.pm * BM + wr * 64 + fr; const int col0 = u.pn * HALF + wc * 32 + 8 * fq;
#pragma unroll
        for (int ai = 0; ai < 2; ++ai)
#pragma unroll
            for (int m = 0; m < 4; ++m) { bf16_t* rowp = O + (size_t)(row0 + ai * HALF + m * 16) * ldc + col0;
                const f32x4 g0 = acc[ai][0][m][0], g1 = acc[ai][0][m][1], u0 = acc[ai][1][m][0], u1 = acc[ai][1][m][1];
                u32x4 w;
                w.x = cvt_pk_bf16(silu_f(g0[0]) * u0[0], silu_f(g0[1]) * u0[1]); w.y = cvt_pk_bf16(silu_f(g0[2]) * u0[2], silu_f(g0[3]) * u0[3]);
                w.z = cvt_pk_bf16(silu_f(g1[0]) * u1[0], silu_f(g1[1]) * u1[1]); w.w = cvt_pk_bf16(silu_f(g1[2]) * u1[2], silu_f(g1[3]) * u1[3]);
                *(u32x4*)rowp = w; }
    }
};
struct EpiF32 {
    static constexpr bool PERM = false, AFTER_DRAIN = false;
    float* O; int ldc;
    __device__ __forceinline__ void operator()(const f32x4 (&acc)[2][2][4][2], const Unit& u, int wr, int wc, int fr, int fq) const {
        const int row0 = u.pm * BM + wr * 64 + fr; const int col0 = u.pn * BM + wc * 32 + 4 * fq;
#pragma unroll
        for (int ai = 0; ai < 2; ++ai)
#pragma unroll
            for (int m = 0; m < 4; ++m) { float* rowp = O + (size_t)(row0 + ai * HALF + m * 16) * ldc + col0;
#pragma unroll
                for (int bj = 0; bj < 2; ++bj)
#pragma unroll
                    for (int n = 0; n < 2; ++n) *(f32x4*)(rowp + bj * HALF + n * 16) = acc[ai][bj][m][n]; }
    }
};
template <class Epi, class Sched, bool ALIGN_EPI = false, bool SP2 = false>
__device__ __forceinline__ void gemm_phase(PG8_LAS unsigned char* lds, const Gemm g, const Sched& S, const Epi& E) {
    int tid_l = threadIdx.x; asm volatile("" : "+v"(tid_l));
    const int tid = tid_l, wid = __builtin_amdgcn_readfirstlane(tid >> 6), lane = tid & 63, wr = wid >> 2, wc = wid & 3, fr = lane & 15, fq = lane >> 4;
    const int K = g.K, nt = K / BK, LD = g.ld;
    unsigned voffA[2], voffB[2];
#pragma unroll
    for (int i = 0; i < 2; ++i) { int R, C; stage_rc(tid * 16 + i * 8192, R, C); const int Rb = Epi::PERM ? ((R & ~31) + perm32(R & 31)) : R;
        voffA[i] = (unsigned)(R * LD + C) * 2u; voffB[i] = (unsigned)(Rb * LD + C) * 2u; }
    const size_t kstep = (size_t)(BK * 2);
    const size_t hstep = (size_t)HALF * LD * 2;
    const size_t tstep = 2 * hstep;
    const unsigned ldsw = (unsigned)wid * 1024u;
    const int aoff = lds_byte(wr * 64 + fr, fq * 8), boff = lds_byte(wc * 32 + fr, fq * 8);
#define PG8_SA(b, h) (((b) * 2 + (h)) * HTB)
#define PG8_SB(b, h) ((4 + (b) * 2 + (h)) * HTB)
#define PG8_STAGE(bufoff, gbase, voff) do { _Pragma("unroll") for (int _i = 0; _i < 2; ++_i) \
        __builtin_amdgcn_global_load_lds((const unsigned*)((const char*)(gbase) + (voff)[_i]), (PG8_LAS unsigned*)(lds + (bufoff) + ldsw + _i * 8192), 16, 0, 0); } while (0)
#define PG8_LDA(dst, b, h) do { _Pragma("unroll") for (int m = 0; m < 4; ++m) _Pragma("unroll") for (int k = 0; k < 2; ++k) dst[m][k] = *(const PG8_LAS bf16x8*)(lds + PG8_SA(b, h) + aoff + m * 2048 + k * 1024); } while (0)
#define PG8_LDB(dst, b, h) do { _Pragma("unroll") for (int n = 0; n < 2; ++n) _Pragma("unroll") for (int k = 0; k < 2; ++k) dst[n][k] = *(const PG8_LAS bf16x8*)(lds + PG8_SB(b, h) + boff + n * 2048 + k * 1024); } while (0)
#define PG8_MMA(ai, bj, At, Bt) do { __builtin_amdgcn_s_setprio(1); _Pragma("unroll") for (int m = 0; m < 4; ++m) _Pragma("unroll") for (int n = 0; n < 2; ++n) _Pragma("unroll") for (int k = 0; k < 2; ++k) \
        acc[ai][bj][m][n] = __builtin_amdgcn_mfma_f32_16x16x32_bf16(Bt[n][k], At[m][k], acc[ai][bj][m][n], 0, 0, 0); __builtin_amdgcn_s_setprio(0); } while (0)
#define PG8_WAIT_V(n) asm volatile("s_waitcnt vmcnt(" #n ")" ::: "memory")
#define PG8_WAIT_L(n) asm volatile("s_waitcnt lgkmcnt(" #n ")" ::: "memory")
#define PG8_BAR __builtin_amdgcn_s_barrier()
#define PG8_SCHED __builtin_amdgcn_sched_barrier(0)
    Unit cur, nxt; int ui = 0;
    if (!S.next(0, cur)) return;
    f32x4 acc[2][2][4][2];
#pragma unroll
    for (int a = 0; a < 2; ++a)
#pragma unroll
        for (int b = 0; b < 2; ++b)
#pragma unroll
            for (int m = 0; m < 4; ++m)
#pragma unroll
                for (int n = 0; n < 2; ++n) acc[a][b][m][n] = (f32x4){0.f, 0.f, 0.f, 0.f};
    bf16x8 At[4][2], B0[2][2], B1[2][2];
    const char* cA = (const char*)g.A + (size_t)cur.pm * tstep; const char* cB = (const char*)g.Bt + (size_t)cur.pn * tstep;
    S.a_ready(cur);
    if constexpr (SP2) {
        PG8_STAGE(PG8_SB(0, 0), cB, voffB); PG8_STAGE(PG8_SB(0, 1), cB + hstep, voffB); PG8_STAGE(PG8_SA(0, 0), cA, voffA); PG8_STAGE(PG8_SA(0, 1), cA + hstep, voffA);
        if (wr == 1) PG8_BAR;
        PG8_WAIT_V(2); PG8_BAR;
        PG8_STAGE(PG8_SB(1, 0), cB + kstep, voffB); PG8_STAGE(PG8_SA(1, 0), cA + kstep, voffA); PG8_STAGE(PG8_SB(1, 1), cB + hstep + kstep, voffB);
        PG8_WAIT_V(6); PG8_BAR;
    } else {
        PG8_STAGE(PG8_SB(0, 0), cB, voffB); PG8_STAGE(PG8_SA(0, 0), cA, voffA); PG8_STAGE(PG8_SB(0, 1), cB + hstep, voffB); PG8_STAGE(PG8_SA(0, 1), cA + hstep, voffA);
        if (wr == 1) PG8_BAR;
        PG8_WAIT_V(4); PG8_BAR;
        PG8_STAGE(PG8_SB(1, 0), cB + kstep, voffB); PG8_STAGE(PG8_SA(1, 0), cA + kstep, voffA); PG8_STAGE(PG8_SB(1, 1), cB + hstep + kstep, voffB);
        PG8_WAIT_V(6); PG8_BAR;
    }
    for (;;) {
        const bool has_next = S.next(ui + 1, nxt);
        const char* nA = has_next ? (const char*)g.A + (size_t)nxt.pm * tstep : cA; const char* nB = has_next ? (const char*)g.Bt + (size_t)nxt.pn * tstep : cB;
        for (int t = 0; t < nt; t += 2) {
            const bool last = (t == nt - 2);
            const char* a1 = cA + (size_t)(t + 1) * kstep;
            const char* a2 = last ? nA : cA + (size_t)(t + 2) * kstep; const char* b2 = last ? nB : cB + (size_t)(t + 2) * kstep;
            const char* a3 = a2 + kstep; const char* b3 = b2 + kstep;
            if (last && has_next) S.a_ready(nxt);
            if constexpr (SP2) {
            PG8_LDB(B0, 0, 0); PG8_LDB(B1, 0, 1); PG8_SCHED; PG8_LDA(At, 0, 0); PG8_STAGE(PG8_SA(1, 1), a1 + hstep, voffA);
            PG8_WAIT_V(8); PG8_WAIT_L(0); PG8_BAR; PG8_MMA(0, 0, At, B0); PG8_MMA(0, 1, At, B1); PG8_BAR; PG8_SCHED;
            PG8_LDA(At, 0, 1); PG8_STAGE(PG8_SB(0, 0), b2, voffB); PG8_STAGE(PG8_SB(0, 1), b2 + hstep, voffB); PG8_STAGE(PG8_SA(0, 0), a2, voffA);
            PG8_WAIT_V(8); PG8_WAIT_L(0); PG8_BAR; PG8_MMA(1, 0, At, B0); PG8_MMA(1, 1, At, B1); PG8_BAR; PG8_SCHED;
            PG8_LDB(B0, 1, 0); PG8_LDB(B1, 1, 1); PG8_SCHED; PG8_LDA(At, 1, 0); PG8_STAGE(PG8_SA(0, 1), a2 + hstep, voffA);
            PG8_WAIT_V(8); PG8_WAIT_L(0); PG8_BAR; PG8_MMA(0, 0, At, B0); PG8_MMA(0, 1, At, B1); PG8_BAR; PG8_SCHED;
            PG8_LDA(At, 1, 1); PG8_STAGE(PG8_SB(1, 0), b3, voffB); PG8_STAGE(PG8_SB(1, 1), b3 + hstep, voffB); PG8_STAGE(PG8_SA(1, 0), a3, voffA);
            PG8_WAIT_V(8); PG8_WAIT_L(0); PG8_BAR; PG8_MMA(1, 0, At, B0); PG8_MMA(1, 1, At, B1); PG8_BAR; PG8_SCHED;
            } else {
            PG8_LDB(B0, 0, 0); PG8_SCHED; PG8_LDA(At, 0, 0); PG8_STAGE(PG8_SA(1, 1), a1 + hstep, voffA);
            PG8_WAIT_L(8); PG8_BAR; PG8_WAIT_L(0); PG8_MMA(0, 0, At, B0); PG8_BAR; PG8_SCHED;
            PG8_LDB(B1, 0, 1); PG8_STAGE(PG8_SB(0, 0), b2, voffB);
            PG8_BAR; PG8_WAIT_L(0); PG8_MMA(0, 1, At, B1); PG8_BAR;
            PG8_LDA(At, 0, 1); PG8_STAGE(PG8_SA(0, 0), a2, voffA);
            PG8_BAR; PG8_WAIT_L(0); PG8_MMA(1, 0, At, B0); PG8_BAR; PG8_SCHED;
            PG8_STAGE(PG8_SB(0, 1), b2 + hstep, voffB);
            PG8_WAIT_V(6); PG8_BAR; PG8_MMA(1, 1, At, B1); PG8_BAR;
            PG8_LDB(B0, 1, 0); PG8_SCHED; PG8_LDA(At, 1, 0); PG8_STAGE(PG8_SA(0, 1), a2 + hstep, voffA);
            PG8_WAIT_L(8); PG8_BAR; PG8_WAIT_L(0); PG8_MMA(0, 0, At, B0); PG8_BAR; PG8_SCHED;
            PG8_LDB(B1, 1, 1); PG8_STAGE(PG8_SB(1, 0), b3, voffB);
            PG8_BAR; PG8_WAIT_L(0); PG8_MMA(0, 1, At, B1); PG8_BAR;
            PG8_LDA(At, 1, 1); PG8_STAGE(PG8_SA(1, 0), a3, voffA);
            PG8_BAR; PG8_WAIT_L(0); PG8_MMA(1, 0, At, B0); PG8_BAR; PG8_SCHED;
            PG8_STAGE(PG8_SB(1, 1), b3 + hstep, voffB);
            PG8_WAIT_V(6); PG8_BAR; PG8_MMA(1, 1, At, B1); PG8_BAR;
            }
        }
        if constexpr (ALIGN_EPI) { if (wr == 0) PG8_BAR; }
        if constexpr (!Epi::AFTER_DRAIN) { E(acc, cur, wr, wc, fr, fq); S.done(cur); }
        if (!has_next) break;
#pragma unroll
        for (int a = 0; a < 2; ++a)
#pragma unroll
            for (int b = 0; b < 2; ++b)
#pragma unroll
                for (int m = 0; m < 4; ++m)
#pragma unroll
                    for (int n = 0; n < 2; ++n) acc[a][b][m][n] = (f32x4){0.f, 0.f, 0.f, 0.f};
        cur = nxt; cA = nA; cB = nB; ++ui;
        if constexpr (ALIGN_EPI) { if (wr == 1) PG8_BAR; }
    }
    PG8_WAIT_V(0);
    if constexpr (!ALIGN_EPI) { if (wr == 0) PG8_BAR; }
    PG8_BAR;
    if constexpr (Epi::AFTER_DRAIN) { E.fused(acc, cur, wr, wc, fr, fq, lds, wid, lane); S.done(cur); }
#undef PG8_SA
#undef PG8_SB
#undef PG8_STAGE
#undef PG8_LDA
#undef PG8_LDB
#undef PG8_MMA
#undef PG8_WAIT_V
#undef PG8_WAIT_L
#undef PG8_BAR
#undef PG8_SCHED
}
}

#define LAS __attribute__((address_space(3)))
typedef unsigned short bf16;
typedef unsigned v4u __attribute__((ext_vector_type(4)));
typedef unsigned v2u __attribute__((ext_vector_type(2)));
typedef float f32x4 __attribute__((ext_vector_type(4)));
typedef float f32x2 __attribute__((ext_vector_type(2)));
typedef short bf16x8 __attribute__((ext_vector_type(8)));

constexpr int T = 16896, TP = 16384, DM = 1024, NSEQ_P = 8, SEQ = 2048, NSEQ_S = 128;
constexpr int GIN = 4112, GINP = 4352, SIN = 5152, SINP = 5376, DFF = 2816, CONVD = 3072;
constexpr float EPS = 1e-6f;
constexpr int LDS_BYTES = 147456;
constexpr size_t MiB = 1u << 20;
constexpr size_t WS_WGIN = 0, WS_WGOUT = 17 * MiB, WS_WSIN = 21 * MiB, WS_WSOUT = 42 * MiB, WS_WGU = 50 * MiB, WS_WDN = 94 * MiB, WS_HN = 116 * MiB,
                 WS_PROJ = 149 * MiB, WS_ACT = WS_PROJ, WS_QKV = 323 * MiB, WS_GB = 422 * MiB, WS_CH = 425 * MiB, WS_GLAST = 569 * MiB, WS_OBUF = 570 * MiB,
                 WS_SSQ = 636 * MiB, WS_GOUT = 639 * MiB, WS_BAR = 705 * MiB, WS_END = 706 * MiB;
constexpr size_t O_Y = 0, O_GSP = (size_t)T * DM, O_GCP = O_GSP + 2ull * 8 * 8 * 128 * 128, O_SHP = O_GCP + 2ull * 8 * 3 * CONVD, O_SCP = O_SHP + 2ull * 8 * 32 * 64 * 128,
                 O_GSS = O_SCP + 2ull * 8 * 3 * CONVD, O_GCS = O_GSS + 2ull * 128 * 8 * 128 * 128, O_SHS = O_GCS + 2ull * 128 * 3 * CONVD, O_SCS = O_SHS + 2ull * 128 * 32 * 64 * 128,
                 O_END = O_SCS + 2ull * 128 * 3 * CONVD;
static_assert(O_END == 129269760ull, "output size");
constexpr int OFF_U = 0, OFF_W = 8192, OFF_QG = 16384, OFF_KDT = 24576, OFF_ATTN = 32768, CHU = 36864;

struct Args { const float* in[27]; float* out; unsigned char* ws; int ph_lo, ph_hi; };

__device__ __forceinline__ float bf2f(unsigned short h) { return __uint_as_float((unsigned)h << 16); }
__device__ __forceinline__ float bflo(unsigned u) { return __uint_as_float(u << 16); }
__device__ __forceinline__ float bfhi(unsigned u) { return __uint_as_float(u & 0xffff0000u); }
__device__ __forceinline__ unsigned pk2(float lo, float hi) { return pg8::cvt_pk_bf16(lo, hi); }
__device__ __forceinline__ unsigned short f2bf(float f) { return (unsigned short)(pg8::cvt_pk_bf16(f, 0.f) & 0xffffu); }
__device__ __forceinline__ float silu_f(float x) { return x * __builtin_amdgcn_rcpf(1.0f + __expf(-x)); }
__device__ __forceinline__ float sigmoid_f(float x) { return __builtin_amdgcn_rcpf(1.0f + __expf(-x)); }
__device__ __forceinline__ float softplus_f(float x) { return fmaxf(x, 0.f) + log1pf(__expf(-fabsf(x))); }
template <int M> __device__ __forceinline__ float shx(float v, int lane) {
    if constexpr (M == 1) return __int_as_float(__builtin_amdgcn_update_dpp(0, __float_as_int(v), 0xB1, 0xf, 0xf, true));
    else if constexpr (M == 2) return __int_as_float(__builtin_amdgcn_update_dpp(0, __float_as_int(v), 0x4E, 0xf, 0xf, true));
    else if constexpr (M == 4) return __int_as_float(__builtin_amdgcn_update_dpp(0, __float_as_int(v), 0x141, 0xf, 0xf, true));
    else if constexpr (M == 8) return __int_as_float(__builtin_amdgcn_update_dpp(0, __float_as_int(v), 0x140, 0xf, 0xf, true));
    else if constexpr (M < 32) return __int_as_float(__builtin_amdgcn_ds_swizzle(__float_as_int(v), (M << 10) | 0x1f));
    else return __int_as_float(__builtin_amdgcn_ds_bpermute((lane ^ 32) << 2, __float_as_int(v)));
}
__device__ __forceinline__ float shi(float v, int src) { return __int_as_float(__builtin_amdgcn_ds_bpermute(src << 2, __float_as_int(v))); }
__device__ __forceinline__ float wave_sum(int lane, float v) {
    v += shx<1>(v, lane); v += shx<2>(v, lane); v += shx<4>(v, lane); v += shx<8>(v, lane); v += shx<16>(v, lane); v += shx<32>(v, lane);
    return v;
}
__device__ __forceinline__ float wave_incl_scan(float v, int lane) {
#pragma unroll
    for (int d = 1; d < 64; d <<= 1) { const float t = shi(v, lane - d); if (lane >= d) v += t; }
    return v;
}
#define REP_BARRIER 0
#ifndef REP_PROMPT
#define REP_PROMPT 1
#endif
__device__ __forceinline__ int tsw_w(int row, int j) { return row * 144 + ((((j >> 3) ^ (row >> 3)) & 7) << 4) + ((j & 7) << 1); }
__device__ __forceinline__ int tsw_r(int row, int gran) { return row * 144 + (((gran ^ (row >> 3)) & 7) << 4); }
__device__ __forceinline__ void st16_wt(void* p, v4u v) { asm volatile("global_store_dwordx4 %0, %1, off sc1\n\ts_nop 1" :: "v"(p), "v"(v) : "memory"); }
#define RLX_AGENT_ __ATOMIC_RELAXED, __HIP_MEMORY_SCOPE_AGENT
__device__ __forceinline__ void wait_flag_set(unsigned* flag, unsigned seen) {
    unsigned v = seen, spins = 0;
    while (__builtin_amdgcn_readfirstlane(v) == 0u && spins < (1u << 22)) { __builtin_amdgcn_s_sleep(2); v = __hip_atomic_load(flag, RLX_AGENT_); ++spins; }
}
#define MFMA16(a, b, c) __builtin_amdgcn_mfma_f32_16x16x32_bf16((a), (b), (c), 0, 0, 0)
#define LDS_WAIT() asm volatile("s_waitcnt lgkmcnt(0)" ::: "memory")
#define BAR_LDS() do { asm volatile("s_waitcnt lgkmcnt(0)" ::: "memory"); __builtin_amdgcn_s_barrier(); asm volatile("" ::: "memory"); } while (0)

#define XB_TMO      128
#define XB_XCNT(j)  (256  + 64 * (j))
#define XB_XSUB(j)  (1280 + 64 * (j))
#define XB_XGEN(j)  (2304 + 64 * (j))
#define XB_TOP      3328
#define XB_TOPGEN   3392
#define XCD_BAR_WORDS 3456
#define XB_SPIN_CAP (1u << 18)

__device__ __forceinline__ unsigned xb_ld(unsigned* p)              { return __hip_atomic_load(p, __ATOMIC_RELAXED, __HIP_MEMORY_SCOPE_AGENT); }
__device__ __forceinline__ unsigned xb_add(unsigned* p, unsigned v) { return __hip_atomic_fetch_add(p, v, __ATOMIC_RELAXED, __HIP_MEMORY_SCOPE_AGENT); }
__device__ __forceinline__ unsigned xb_xcc_id() { return (unsigned)__builtin_amdgcn_s_getreg((3 << 11) | 20) & 0xFu; }
#define XB_SPIN(cond, bar) do { unsigned _sp = 0; while (cond) { __builtin_amdgcn_s_sleep(1); \
    if ((++_sp & 255u) == 0u) { if (xb_ld(&(bar)[XB_TMO])) break; if (_sp > XB_SPIN_CAP) { atomicAdd(&(bar)[XB_TMO], 1u); break; } } } } while (0)

struct XcdBarrier {
    unsigned* bar; unsigned x;
    volatile LAS unsigned* st;
};

__device__ __forceinline__ XcdBarrier xcd_barrier_post(unsigned* bar, volatile LAS unsigned* st) {
    XcdBarrier b; b.bar = bar; b.x = xb_xcc_id(); b.st = st;
    if (threadIdx.x == 0) (void)xb_add(&bar[XB_XCNT(b.x)], 1u);
    return b;
}
__device__ __forceinline__ void xcd_barrier_complete(unsigned* bar, unsigned x, unsigned& nloc, unsigned& nx) {
    const unsigned G = gridDim.x * gridDim.y * gridDim.z;
    unsigned sum, cnt, mine, sp = 0u;
    for (;;) {
        sum = 0u; cnt = 0u; mine = 0u;
#pragma unroll
        for (unsigned j = 0; j < 16; ++j) { const unsigned c = xb_ld(&bar[XB_XCNT(j)]); sum += c; cnt += (c > 0u) ? 1u : 0u; mine = (j == x) ? c : mine; }
        if (sum == G) break;
        __builtin_amdgcn_s_sleep(1);
        if ((++sp & 255u) == 0u) { if (xb_ld(&bar[XB_TMO])) break; if (sp > XB_SPIN_CAP) { atomicAdd(&bar[XB_TMO], 1u); break; } }
    }
    nloc = mine > 0u ? mine : 1u; nx = cnt > 0u ? cnt : 1u;
}

__device__ __forceinline__ void xcd_barrier(const XcdBarrier& b) {
    asm volatile("s_waitcnt vmcnt(0)" ::: "memory");
    __syncthreads();
    if (threadIdx.x == 0) {
        unsigned* bar = b.bar;
        __builtin_amdgcn_s_waitcnt(0);
        unsigned nloc = b.st[0], nx = b.st[1];
        if (nloc == 0u) { xcd_barrier_complete(bar, b.x, nloc, nx); b.st[0] = nloc; b.st[1] = nx; }
        const unsigned old = xb_add(&bar[XB_XSUB(b.x)], 1u);
        const unsigned gen = old / nloc;
        if (old + 1u == (gen + 1u) * nloc) {
            __builtin_amdgcn_fence(__ATOMIC_RELEASE, "agent");
            asm volatile("s_waitcnt vmcnt(0)" ::: "memory");
            const unsigned og = xb_add(&bar[XB_TOP], 1u);
            const unsigned tg = og / nx;
            if (og + 1u == (tg + 1u) * nx) xb_add(&bar[XB_TOPGEN], 1u);
            else XB_SPIN(xb_ld(&bar[XB_TOPGEN]) == tg, bar);
            __builtin_amdgcn_fence(__ATOMIC_ACQUIRE, "agent");
            xb_add(&bar[XB_XGEN(b.x)], 1u);
            asm volatile("s_waitcnt vmcnt(0)" ::: "memory");
        } else {
            XB_SPIN(xb_ld(&bar[XB_XGEN(b.x)]) == gen, bar);
            __builtin_amdgcn_fence(__ATOMIC_ACQUIRE, "agent");
            asm volatile("s_waitcnt vmcnt(0)" ::: "memory");
        }
    }
    __syncthreads();
}


__device__ __forceinline__ void tr_item(const float* __restrict__ W, int K, int N, bf16* WT, const float* __restrict__ ks, int mode, LAS float* scr, int item, int nblk, int lane) {
    const int kb = item / nblk, nb = item - kb * nblk, k0 = 64 * kb, n0 = 64 * nb;
    const int nn = n0 + 4 * (lane & 15); const bool ok = nn < N;
    f32x4 v[16];
#pragma unroll
    for (int i = 0; i < 16; ++i) { const int kk = 4 * i + (lane >> 4); v[i] = ok ? *(const f32x4*)(W + (size_t)(k0 + kk) * N + nn) : (f32x4){0.f, 0.f, 0.f, 0.f}; }
    if (ks) {
#pragma unroll
        for (int i = 0; i < 16; ++i) v[i] = v[i] * ks[k0 + 4 * i + (lane >> 4)];
    }
#pragma unroll
    for (int i = 0; i < 16; ++i) { const int kk = 4 * i + (lane >> 4); LAS float* d = scr + kk * 65 + 4 * (lane & 15); d[0] = v[i].x; d[1] = v[i].y; d[2] = v[i].z; d[3] = v[i].w; }
    LDS_WAIT();
    const int c = lane & 7;
#pragma unroll
    for (int jx = 0; jx < 8; ++jx) { const int n = (lane >> 3) + 8 * jx; const LAS float* sp = scr + (8 * c) * 65 + n;
        v4u o; o.x = pk2(sp[0 * 65], sp[1 * 65]); o.y = pk2(sp[2 * 65], sp[3 * 65]); o.z = pk2(sp[4 * 65], sp[5 * 65]); o.w = pk2(sp[6 * 65], sp[7 * 65]);
        const int nr = n0 + n; const int dr = mode == 0 ? nr : (((nr >> 7) << 8) + (nr & 127) + (mode == 2 ? 128 : 0));
        *(v4u*)(WT + (size_t)dr * K + k0 + 8 * c) = o; }
    LDS_WAIT();
}
constexpr int I_GIN = 16 * (GINP / 64), I_GOUT = 16 * 16, I_SIN = 16 * (SINP / 64), I_SOUT = 32 * 16, I_GU = 16 * (DFF / 64), I_DN = (DFF / 64) * 16;
constexpr int O_GIN = 0, O_GOUT = 2 * I_GIN, O_SIN = O_GOUT + 2 * I_GOUT, O_SOUT = O_SIN + 2 * I_SIN, O_GU = O_SOUT + 2 * I_SOUT, O_DN = O_GU + 8 * I_GU;
__device__ __forceinline__ void cvt_item(const Args& a, LAS float* scr, int it, int lane) {
    unsigned char* ws = a.ws; int r = it;
    if (r < 2 * I_GIN) { const int j = r / I_GIN; r -= j * I_GIN; tr_item(a.in[10] + (size_t)j * DM * GIN, DM, GIN, (bf16*)(ws + WS_WGIN) + (size_t)j * GINP * DM, a.in[6] + (2 * j) * DM, 0, scr, r, GINP / 64, lane); return; }
    r -= 2 * I_GIN;
    if (r < 2 * I_GOUT) { const int j = r / I_GOUT; r -= j * I_GOUT; tr_item(a.in[15] + (size_t)j * DM * DM, DM, DM, (bf16*)(ws + WS_WGOUT) + (size_t)j * DM * DM, nullptr, 0, scr, r, DM / 64, lane); return; }
    r -= 2 * I_GOUT;
    if (r < 2 * I_SIN) { const int j = r / I_SIN; r -= j * I_SIN; tr_item(a.in[16] + (size_t)j * DM * SIN, DM, SIN, (bf16*)(ws + WS_WSIN) + (size_t)j * SINP * DM, a.in[6] + (2 * j + 1) * DM, 0, scr, r, SINP / 64, lane); return; }
    r -= 2 * I_SIN;
    if (r < 2 * I_SOUT) { const int j = r / I_SOUT; r -= j * I_SOUT; tr_item(a.in[23] + (size_t)j * 2048 * DM, 2048, DM, (bf16*)(ws + WS_WSOUT) + (size_t)j * DM * 2048, a.in[22] + j * 2048, 0, scr, r, DM / 64, lane); return; }
    r -= 2 * I_SOUT;
    if (r < 8 * I_GU) { const int q = r / I_GU; r -= q * I_GU; const int i = q >> 1, up = q & 1;
        tr_item(a.in[up ? 25 : 24] + (size_t)i * DM * DFF, DM, DFF, (bf16*)(ws + WS_WGU) + (size_t)i * 2 * DFF * DM, a.in[8] + i * DM, up ? 2 : 1, scr, r, DFF / 64, lane); return; }
    r -= 8 * I_GU;
    { const int i = r / I_DN; r -= i * I_DN; tr_item(a.in[26] + (size_t)i * DFF * DM, DFF, DM, (bf16*)(ws + WS_WDN) + (size_t)i * DM * DFF, nullptr, 0, scr, r, DM / 64, lane); }
}
constexpr int CV_NR = 16;
constexpr int CV_ST[CV_NR] = {O_GIN, O_GOUT, O_GU, O_DN,   O_SIN, O_SOUT, O_GU + 2 * I_GU, O_DN + I_DN,   O_GIN + I_GIN, O_GOUT + I_GOUT, O_GU + 4 * I_GU, O_DN + 2 * I_DN,   O_SIN + I_SIN, O_SOUT + I_SOUT, O_GU + 6 * I_GU, O_DN + 3 * I_DN};
constexpr int CV_LN[CV_NR] = {I_GIN, I_GOUT, 2 * I_GU, I_DN,   I_SIN, I_SOUT, 2 * I_GU, I_DN,   I_GIN, I_GOUT, 2 * I_GU, I_DN,   I_SIN, I_SOUT, 2 * I_GU, I_DN};
constexpr int CV_N0 = I_GIN + I_GOUT + 2 * I_GU + I_DN;
constexpr int CV_TOTAL = 2 * (I_GIN + I_GOUT + I_SIN + I_SOUT) + 4 * (2 * I_GU + I_DN);
__host__ __device__ constexpr int CV_WB(int w) { return w <= 0 ? 0 : w == 1 ? 2200 : w == 2 ? 3350 : w == 3 ? 5450 : w == 4 ? 6600 : w == 5 ? 8800 : w == 6 ? 9950 : (CV_TOTAL - CV_N0); }
static_assert(CV_TOTAL - CV_N0 == 11392, "conversion item count");
__device__ __forceinline__ void phase_convert(const Args& a, LAS unsigned char* lds, int lo, int hi, int worker, int nworkers, int wave, int lane) {
    LAS float* scr = (LAS float*)(lds + wave * 16640);
    for (int v = lo + worker; v < hi; v += nworkers) {
        int r = v, it = 0; bool done = false;
#pragma unroll
        for (int rr = 0; rr < CV_NR; ++rr) { if (!done) { if (r < CV_LN[rr]) { it = CV_ST[rr] + r; done = true; } else r -= CV_LN[rr]; } }
        cvt_item(a, scr, it, lane);
    }
}
__device__ __forceinline__ void phase_prologue(const Args& a, LAS unsigned char* lds, int wave, int lane, int bid, int G) {
    const int gw = bid * 8 + wave, NGW = G * 8;
    unsigned char* ws = a.ws;
    bf16* hn = (bf16*)(ws + WS_HN);
    for (int m = gw; m < T; m += NGW) {
        const float* xrow = m < TP ? a.in[0] + (size_t)m * DM : a.in[1] + (size_t)(m - TP) * DM;
        f32x4 v[4]; float s = 0.f;
#pragma unroll
        for (int jx = 0; jx < 4; ++jx) { v[jx] = *(const f32x4*)(xrow + 4 * lane + 256 * jx); s += (v[jx].x * v[jx].x + v[jx].y * v[jx].y) + (v[jx].z * v[jx].z + v[jx].w * v[jx].w); }
        const float rstd = rsqrtf(wave_sum(lane, s) * (1.f / DM) + EPS);
#pragma unroll
        for (int jx = 0; jx < 4; ++jx) { v2u o; o.x = pk2(v[jx].x * rstd, v[jx].y * rstd); o.y = pk2(v[jx].z * rstd, v[jx].w * rstd); *(v2u*)(hn + (size_t)m * DM + 4 * lane + 256 * jx) = o; }
    }
}

__device__ __forceinline__ void phase_res(const Args& a, int L, bool ffn, int m_lo, int m_hi, int gw, int NGW, int lane, const bf16* gout2, int np2) {
    const bf16* gout = (const bf16*)(a.ws + WS_GOUT);
    const float* postw = (ffn ? a.in[9] : a.in[7]) + L * DM;
    const bool ssd_mix = !ffn && (L & 1);
    const bool first = !ffn && L == 0;
    const float* ssq = (const float*)(a.ws + WS_SSQ);
    bf16* hn = (bf16*)(a.ws + WS_HN);
    f32x4 pw[4];
#pragma unroll
    for (int jx = 0; jx < 4; ++jx) pw[jx] = *(const f32x4*)(postw + 4 * lane + 256 * jx);
    float* sc = (float*)(a.ws + WS_GLAST + 262144);
    const bool last = ffn && L == 3;
    v2u og[4], og2[4], hr[4]; f32x4 xf[4]; float xs_n = 1.f, p_n = 0.f;
#define RES_LOAD(mm) do { const int m_ = (mm);         _Pragma("unroll") for (int jx = 0; jx < 4; ++jx) { og[jx] = *(const v2u*)(gout + (size_t)m_ * DM + 4 * lane + 256 * jx);             if (gout2) og2[jx] = *(const v2u*)(gout2 + (size_t)m_ * DM + 4 * lane + 256 * jx);             if (first) xf[jx] = *(const f32x4*)((m_ < TP ? a.in[0] + (size_t)m_ * DM : a.in[1] + (size_t)(m_ - TP) * DM) + 4 * lane + 256 * jx);             else hr[jx] = *(const v2u*)(hn + (size_t)m_ * DM + 4 * lane + 256 * jx); }         if (!first) xs_n = sc[m_];         if (ssd_mix) p_n = lane < 32 ? ssq[(size_t)m_ * 32 + lane] : 0.f; } while (0)
    int m = m_lo + gw;
    if (m < m_hi) RES_LOAD(m);
    for (; m < m_hi; m += NGW) {
        f32x4 o[4], x[4]; float ss = 0.f; const float xs = first ? 1.f : xs_n; float p = p_n;
#pragma unroll
        for (int jx = 0; jx < 4; ++jx) { o[jx] = (f32x4){bflo(og[jx].x), bfhi(og[jx].x), bflo(og[jx].y), bfhi(og[jx].y)};
            if (gout2) { o[jx] = o[jx] + (f32x4){bflo(og2[jx].x), bfhi(og2[jx].x), bflo(og2[jx].y), bfhi(og2[jx].y)};
                for (int e = 1; e < np2; ++e) { const v2u g3 = *(const v2u*)(gout2 + (size_t)e * (T - TP) * DM + (size_t)m * DM + 4 * lane + 256 * jx); o[jx] = o[jx] + (f32x4){bflo(g3.x), bfhi(g3.x), bflo(g3.y), bfhi(g3.y)}; } }
            if (first) x[jx] = xf[jx]; else x[jx] = (f32x4){bflo(hr[jx].x), bfhi(hr[jx].x), bflo(hr[jx].y), bfhi(hr[jx].y)};
            ss += (o[jx].x * o[jx].x + o[jx].y * o[jx].y) + (o[jx].z * o[jx].z + o[jx].w * o[jx].w); }
        RES_LOAD(m + NGW < m_hi ? m + NGW : m);
        float eps_eff = EPS;
        if (ssd_mix) { p = wave_sum(lane, p); eps_eff = EPS * (p * (1.f / 2048.f) + EPS); }
        const float r1 = rsqrtf(wave_sum(lane, ss) * (1.f / DM) + eps_eff);
        float s2 = 0.f;
#pragma unroll
        for (int jx = 0; jx < 4; ++jx) { x[jx] = x[jx] * xs + o[jx] * r1 * pw[jx]; s2 += (x[jx].x * x[jx].x + x[jx].y * x[jx].y) + (x[jx].z * x[jx].z + x[jx].w * x[jx].w);
            if (last) *(f32x4*)(a.out + (size_t)m * DM + 4 * lane + 256 * jx) = x[jx]; }
        const float s2m = wave_sum(lane, s2) * (1.f / DM) + EPS; const float r2 = rsqrtf(s2m);
        if (!last) {
#pragma unroll
            for (int jx = 0; jx < 4; ++jx) { v2u w; w.x = pk2(x[jx].x * r2, x[jx].y * r2); w.y = pk2(x[jx].z * r2, x[jx].w * r2); *(v2u*)(hn + (size_t)m * DM + 4 * lane + 256 * jx) = w; }
            if (lane == 0) sc[m] = s2m * r2;
        }
    }
#undef RES_LOAD
}

template <bool GDN>
__device__ __forceinline__ void phase_conv(const Args& a, int j, int wave, int lane, int bid, int G) {
    const int gw = bid * 8 + wave, NGW = G * 8;
    const bf16* proj = (const bf16*)(a.ws + WS_PROJ); const int ldc = GDN ? GINP : SINP; const int pc0 = GDN ? 0 : 2048;
    bf16* qkv = (bf16*)(a.ws + WS_QKV);
    const float* cw = (GDN ? a.in[11] : a.in[17]) + (size_t)j * 4 * CONVD;
    const float* cb = a.in[18] + (size_t)j * CONVD;
    const float* cst = (GDN ? a.in[3] : a.in[5]) + (size_t)j * NSEQ_S * 3 * CONVD;
    float* ocp = a.out + (GDN ? O_GCP : O_SCP) + (size_t)j * NSEQ_P * 3 * CONVD;
    float* ocs = a.out + (GDN ? O_GCS : O_SCS) + (size_t)j * NSEQ_S * 3 * CONVD;
    constexpr int NPI = (TP / 16) * 6, NSI = NSEQ_S * 6;
    for (int it = gw; it < NPI + NSI; it += NGW) {
        const bool samp = it >= NPI; const int r = samp ? it - NPI : it; const int sec = r % 6, rb = r / 6;
        const int c = sec * 512 + 8 * lane;
        float w[4][8], bias[8], xa[8], xb[8], xc[8];
#pragma unroll
        for (int jj = 0; jj < 4; ++jj) { const f32x4 wl = *(const f32x4*)(cw + jj * CONVD + c), wh = *(const f32x4*)(cw + jj * CONVD + c + 4);
            w[jj][0] = wl.x; w[jj][1] = wl.y; w[jj][2] = wl.z; w[jj][3] = wl.w; w[jj][4] = wh.x; w[jj][5] = wh.y; w[jj][6] = wh.z; w[jj][7] = wh.w; }
#pragma unroll
        for (int e = 0; e < 8; ++e) bias[e] = GDN ? 0.f : cb[c + e];
        int m0, nrows, bq = 0, t0 = 0;
#define CV_UNPACK(dst, q) do { dst[0] = bflo(q.x); dst[1] = bfhi(q.x); dst[2] = bflo(q.y); dst[3] = bfhi(q.y); dst[4] = bflo(q.z); dst[5] = bfhi(q.z); dst[6] = bflo(q.w); dst[7] = bfhi(q.w); } while (0)
        if (!samp) { bq = rb >> 7; t0 = (rb & 127) * 16; m0 = bq * SEQ + t0; nrows = 16;
            if (t0 != 0) { const v4u ra = *(const v4u*)(proj + (size_t)(m0 - 3) * ldc + pc0 + c), rbb = *(const v4u*)(proj + (size_t)(m0 - 2) * ldc + pc0 + c), rc = *(const v4u*)(proj + (size_t)(m0 - 1) * ldc + pc0 + c);
                CV_UNPACK(xa, ra); CV_UNPACK(xb, rbb); CV_UNPACK(xc, rc); }
            else {
#pragma unroll
                for (int e = 0; e < 8; ++e) { xa[e] = 0.f; xb[e] = 0.f; xc[e] = 0.f; } }
        } else { m0 = TP + 4 * rb; nrows = 4;
#pragma unroll
            for (int hh = 0; hh < 2; ++hh) { const f32x4 va = *(const f32x4*)(cst + ((size_t)rb * 3 + 0) * CONVD + c + 4 * hh), vb = *(const f32x4*)(cst + ((size_t)rb * 3 + 1) * CONVD + c + 4 * hh), vc = *(const f32x4*)(cst + ((size_t)rb * 3 + 2) * CONVD + c + 4 * hh);
                xa[4 * hh] = va.x; xa[4 * hh + 1] = va.y; xa[4 * hh + 2] = va.z; xa[4 * hh + 3] = va.w; xb[4 * hh] = vb.x; xb[4 * hh + 1] = vb.y; xb[4 * hh + 2] = vb.z; xb[4 * hh + 3] = vb.w;
                xc[4 * hh] = vc.x; xc[4 * hh + 1] = vc.y; xc[4 * hh + 2] = vc.z; xc[4 * hh + 3] = vc.w; } }
        v4u rawv[16];
#pragma unroll
        for (int i = 0; i < 16; ++i) { const int ii = i < nrows ? i : nrows - 1; rawv[i] = *(const v4u*)(proj + (size_t)(m0 + ii) * ldc + pc0 + c); }
#pragma unroll
        for (int i = 0; i < 16; ++i) { if (i < nrows) {
            const v4u raw = rawv[i];
            float x[8], y[8]; CV_UNPACK(x, raw);
            float ss = 0.f;
#pragma unroll
            for (int e = 0; e < 8; ++e) { y[e] = silu_f(xa[e] * w[0][e] + xb[e] * w[1][e] + xc[e] * w[2][e] + x[e] * w[3][e] + bias[e]); ss += y[e] * y[e]; }
            if (GDN && sec < 4) { ss += shx<1>(ss, lane); ss += shx<2>(ss, lane); ss += shx<4>(ss, lane); ss += shx<8>(ss, lane);
                const float sc = rsqrtf(ss + 1e-6f) * (sec < 2 ? 0.08838834764831845f : 1.f);
#pragma unroll
                for (int e = 0; e < 8; ++e) y[e] *= sc; }
            v4u o; o.x = pk2(y[0], y[1]); o.y = pk2(y[2], y[3]); o.z = pk2(y[4], y[5]); o.w = pk2(y[6], y[7]);
            *(v4u*)(qkv + (size_t)(m0 + i) * CONVD + c) = o;
            float* cn = nullptr;
            if (!samp) { if (t0 + 16 == SEQ && i >= 13) cn = ocp + ((size_t)bq * 3 + (i - 13)) * CONVD + c; }
            else if (i >= 1) cn = ocs + ((size_t)rb * 3 + (i - 1)) * CONVD + c;
            if (cn) { *(f32x4*)cn = (f32x4){x[0], x[1], x[2], x[3]}; *(f32x4*)(cn + 4) = (f32x4){x[4], x[5], x[6], x[7]}; }
#pragma unroll
            for (int e = 0; e < 8; ++e) { xa[e] = xb[e]; xb[e] = xc[e]; xc[e] = x[e]; }
        } }
#undef CV_UNPACK
    }
    const int gt = bid * 512 + wave * 64 + lane, NT = G * 512;
    float* gb = (float*)(a.ws + WS_GB);
    if (GDN) {
        const float* Alog = a.in[12] + j * 8; const float* dtb = a.in[13] + j * 8;
        for (int idx = gt; idx < T * 8; idx += NT) { const int m = idx >> 3, h = idx & 7;
            const float bb = bf2f(proj[(size_t)m * ldc + 4096 + h]), aa = bf2f(proj[(size_t)m * ldc + 4104 + h]);
            gb[(size_t)m * 16 + h] = sigmoid_f(bb); gb[(size_t)m * 16 + 8 + h] = -__expf(Alog[h]) * softplus_f(aa + dtb[h]); }
    } else {
        const float* dtb = a.in[19] + j * 32;
        for (int idx = gt; idx < T * 32; idx += NT) { const int m = idx >> 5, h = idx & 31;
            gb[(size_t)m * 32 + h] = softplus_f(bf2f(proj[(size_t)m * ldc + 5120 + h]) + dtb[h]); }
    }
}

__device__ __forceinline__ void phase_gp(const Args& a, int jl, LAS unsigned char* lds, int tid, int wave, int lane, int bid, int G) {
    const bf16* qkv = (const bf16*)(a.ws + WS_QKV); const float* gb = (const float*)(a.ws + WS_GB);
    bf16* ch = (bf16*)(a.ws + WS_CH); float* glast = (float*)(a.ws + WS_GLAST);
    constexpr int MF = 0, GLo = 16384, BLo = 16640, EGo = 16896, QL = 17408, KL = 34816, VL = 52224;
    constexpr int XTo = 69632, ATOo = XTo + 36864, SCRo = ATOo + 8192;
    LAS unsigned short* ATOs = (LAS unsigned short*)(lds + ATOo);
    LAS float* GLf = (LAS float*)(lds + GLo); LAS float* BLf = (LAS float*)(lds + BLo); LAS float* EGf = (LAS float*)(lds + EGo); LAS float* MFf = (LAS float*)(lds + MF);
    const int fr = lane & 15, fq = lane >> 4;
    unsigned* gpflag = (unsigned*)(a.ws + WS_BAR + 16384) + jl * 2048;
    v4u pf[6]; float pbe = 0.f, pg_ = 0.f;
#define GP_PREF(qq) do { const int q_ = (qq); const int uid_ = (q_ & 63) * 32 + (q_ >> 6); const int n_ = uid_ & 31, bh_ = uid_ >> 5, h_ = bh_ & 7, b_ = bh_ >> 3; const int mm = b_ * SEQ + n_ * 64; \
        _Pragma("unroll") for (int r = 0; r < 6; ++r) { const int cidx = tid + 512 * r, sect = cidx >> 10, rem = cidx & 1023, row = rem >> 4, cc = rem & 15; \
            pf[r] = *(const v4u*)(qkv + (size_t)(mm + row) * CONVD + sect * 1024 + h_ * 128 + cc * 8); } \
        pbe = gb[(size_t)(mm + lane) * 16 + h_]; pg_ = gb[(size_t)(mm + lane) * 16 + 8 + h_]; } while (0)
    if (bid - 64 < 2048) GP_PREF(bid - 64);
    for (int q = bid - 64; q < 2048; q += G - 64) {
        const int uid = (q & 63) * 32 + (q >> 6);
        bf16* chu = ch + (size_t)uid * CHU;
#pragma unroll
        for (int r = 0; r < 6; ++r) { const int cidx = tid + 512 * r, sect = cidx >> 10, rem = cidx & 1023, row = rem >> 4, cc = rem & 15;
            *(LAS v4u*)(lds + QL + sect * 17408 + row * 272 + cc * 16) = pf[r]; }
        const float be = pbe, g = pg_;
        GP_PREF(q + G - 64 < 2048 ? q + G - 64 : q);
        if (wave == 0) { const float Gc = wave_incl_scan(g, lane);
            GLf[lane] = Gc; BLf[lane] = be; const float eg = __expf(Gc); EGf[lane] = eg; if (lane == 63) __hip_atomic_store((unsigned*)(glast + uid), __float_as_uint(eg), RLX_AGENT_); }
        BAR_LDS();
        {   const int mat = wave >> 2, tr = wave & 3;
            const LAS unsigned char* Ab = lds + (mat == 0 ? KL : QL);
            bf16x8 af[4];
#pragma unroll
            for (int kk = 0; kk < 4; ++kk) af[kk] = *(const LAS bf16x8*)(Ab + (tr * 16 + fr) * 272 + (kk * 32 + fq * 8) * 2);
#pragma unroll
            for (int tc = 0; tc < 4; ++tc) {
                const int jcol = tc * 16 + fr;
                if (tc <= tr) {
                    f32x4 acc = {0.f, 0.f, 0.f, 0.f};
#pragma unroll
                    for (int kk = 0; kk < 4; ++kk) { const bf16x8 bfr = *(const LAS bf16x8*)(lds + KL + (tc * 16 + fr) * 272 + (kk * 32 + fq * 8) * 2); acc = MFMA16(af[kk], bfr, acc); }
                    const float Gj = GLf[jcol];
#pragma unroll
                    for (int r = 0; r < 4; ++r) { const int i = tr * 16 + fq * 4 + r; const float Gi = GLf[i];
                        const float e = (i >= jcol) ? __expf(Gi - Gj) : 0.f;
                        if (mat == 0) MFf[i * 64 + jcol] = (i > jcol) ? BLf[i] * acc[r] * e : 0.f;
                        else ATOs[i * 64 + jcol] = f2bf(acc[r] * e); }
                } else if (mat == 1) {
#pragma unroll
                    for (int r = 0; r < 4; ++r) { const int i = tr * 16 + fq * 4 + r; ATOs[i * 64 + jcol] = 0; }
                }
            }
        }
        BAR_LDS();
        if (tid < 256) {
            const bool isU = tid < 128; const int cc = tid & 127;
            const LAS unsigned char* src = lds + (isU ? VL : KL);
            LAS unsigned char* xt = lds + XTo + tid * 144;
            LAS unsigned char* scr = lds + SCRo + wave * 5120;
            float rr[16];
#pragma unroll
            for (int ib = 0; ib < 4; ++ib) {
                const int i0 = 16 * ib;
#pragma unroll
                for (int r = 0; r < 16; ++r) { const float egi = EGf[i0 + r]; rr[r] = bf2f(*(const LAS unsigned short*)(src + (i0 + r) * 272 + cc * 2)) * BLf[i0 + r] * (isU ? 1.0f : egi); }
                if (ib > 0) {
                    const bool v0 = 8 * fq < i0;
                    bf16x8 a0 = {0, 0, 0, 0, 0, 0, 0, 0}, a1 = {0, 0, 0, 0, 0, 0, 0, 0};
                    if (v0) { const f32x4 m0 = *(const LAS f32x4*)(lds + MF + ((i0 + fr) * 64 + 8 * fq) * 4), m1 = *(const LAS f32x4*)(lds + MF + ((i0 + fr) * 64 + 8 * fq + 4) * 4);
                        v4u p; p.x = pk2(m0.x, m0.y); p.y = pk2(m0.z, m0.w); p.z = pk2(m1.x, m1.y); p.w = pk2(m1.z, m1.w); a0 = __builtin_bit_cast(bf16x8, p); }
                    if (ib == 3 && fq < 2) { const f32x4 m0 = *(const LAS f32x4*)(lds + MF + ((i0 + fr) * 64 + 32 + 8 * fq) * 4), m1 = *(const LAS f32x4*)(lds + MF + ((i0 + fr) * 64 + 32 + 8 * fq + 4) * 4);
                        v4u p; p.x = pk2(m0.x, m0.y); p.y = pk2(m0.z, m0.w); p.z = pk2(m1.x, m1.y); p.w = pk2(m1.z, m1.w); a1 = __builtin_bit_cast(bf16x8, p); }
#pragma unroll
                    for (int t = 0; t < 4; ++t) {
                        const LAS unsigned char* xc = lds + XTo + (wave * 64 + t * 16 + fr) * 144;
                        bf16x8 b0 = {0, 0, 0, 0, 0, 0, 0, 0};
                        if (v0) b0 = *(const LAS bf16x8*)(xc + 16 * fq);
                        f32x4 acc = {0.f, 0.f, 0.f, 0.f};
                        acc = MFMA16(a0, b0, acc);
                        if (ib == 3) { bf16x8 b1 = {0, 0, 0, 0, 0, 0, 0, 0}; if (fq < 2) b1 = *(const LAS bf16x8*)(xc + 64 + 16 * fq); acc = MFMA16(a1, b1, acc); }
                        *(LAS f32x4*)(scr + (t * 16 + fr) * 80 + 16 * fq) = acc;
                    }
                    LDS_WAIT();
#pragma unroll
                    for (int q4 = 0; q4 < 4; ++q4) { const f32x4 d = *(const LAS f32x4*)(scr + lane * 80 + 16 * q4); rr[4 * q4] -= d.x; rr[4 * q4 + 1] -= d.y; rr[4 * q4 + 2] -= d.z; rr[4 * q4 + 3] -= d.w; }
                    LDS_WAIT();
                }
#pragma unroll
                for (int rb = 0; rb < 4; ++rb) {
#pragma unroll
                    for (int r = 4 * rb; r < 4 * rb + 4; ++r) {
#pragma unroll
                        for (int r2 = 0; r2 < r; ++r2) rr[r] -= MFf[(i0 + r) * 64 + i0 + r2] * rr[r2]; }
                    asm volatile("" : "+v"(rr[4 * rb]), "+v"(rr[4 * rb + 1]), "+v"(rr[4 * rb + 2]), "+v"(rr[4 * rb + 3]) :: "memory");
                }
                v4u o0, o1; o0.x = pk2(rr[0], rr[1]); o0.y = pk2(rr[2], rr[3]); o0.z = pk2(rr[4], rr[5]); o0.w = pk2(rr[6], rr[7]);
                o1.x = pk2(rr[8], rr[9]); o1.y = pk2(rr[10], rr[11]); o1.z = pk2(rr[12], rr[13]); o1.w = pk2(rr[14], rr[15]);
                *(LAS v4u*)(xt + 32 * ib) = o0; *(LAS v4u*)(xt + 32 * ib + 16) = o1;
                LDS_WAIT();
            }
        } else {
            const int tt = tid - 256;
#pragma unroll
            for (int r = 0; r < 4; ++r) { const int chunk = tt + 256 * r, row = chunk >> 4, cch = chunk & 15;
                const v4u qv = *(const LAS v4u*)(lds + QL + row * 272 + cch * 16); const float e = EGf[row];
                v4u o; o.x = pk2(bflo(qv.x) * e, bfhi(qv.x) * e); o.y = pk2(bflo(qv.y) * e, bfhi(qv.y) * e); o.z = pk2(bflo(qv.z) * e, bfhi(qv.z) * e); o.w = pk2(bflo(qv.w) * e, bfhi(qv.w) * e);
                st16_wt(chu + OFF_QG + row * 128 + cch * 8, o); }
            const float Gl = GLf[63];
#pragma unroll
            for (int r = 0; r < 4; ++r) { const int chunk = tt + 256 * r, kk = chunk & 127, cg8 = chunk >> 7;
                float v[8];
#pragma unroll
                for (int e = 0; e < 8; ++e) { const int ci = cg8 * 8 + e; v[e] = bf2f(*(const LAS unsigned short*)(lds + KL + ci * 272 + kk * 2)) * __expf(Gl - GLf[ci]); }
                v4u o; o.x = pk2(v[0], v[1]); o.y = pk2(v[2], v[3]); o.z = pk2(v[4], v[5]); o.w = pk2(v[6], v[7]);
                st16_wt(chu + OFF_KDT + kk * 64 + cg8 * 8, o); }
        }
        BAR_LDS();
#pragma unroll
        for (int r = 0; r < 4; ++r) { const int chunk = tid + 512 * r, mcol = (chunk >> 10) * 128 + (chunk & 15) * 8, row = (chunk & 1023) >> 4;
            unsigned short e8[8];
#pragma unroll
            for (int e = 0; e < 8; ++e) e8[e] = *(const LAS unsigned short*)(lds + XTo + (mcol + e) * 144 + row * 2);
            v4u o; o.x = e8[0] | ((unsigned)e8[1] << 16); o.y = e8[2] | ((unsigned)e8[3] << 16); o.z = e8[4] | ((unsigned)e8[5] << 16); o.w = e8[6] | ((unsigned)e8[7] << 16);
            st16_wt(chu + OFF_U + chunk * 8, o); }
        st16_wt(chu + OFF_ATTN + tid * 8, *(const LAS v4u*)(lds + ATOo + tid * 16));
        asm volatile("s_waitcnt vmcnt(0)" ::: "memory");
        __syncthreads();
        if (tid == 0) __hip_atomic_store(gpflag + uid, 1u, RLX_AGENT_);
    }
}

__device__ __forceinline__ void phase_gs(const Args& a, int j, LAS unsigned char* lds, int tid, int wave, int lane, int bid, int G) {
    constexpr int WL = 0, QGL = 17408, UL = 34816, KDTL = 52224, ATL = 70656, SBL = 79872, VNL = 114688;
    const bf16* ch = (const bf16*)(a.ws + WS_CH); const float* glast = (const float*)(a.ws + WS_GLAST);
    const bf16* proj = (const bf16*)(a.ws + WS_PROJ); bf16* obuf = (bf16*)(a.ws + WS_OBUF);
    const float* nw = a.in[14] + j * 128;
    const int fr = lane & 15, fq = lane >> 4, row8 = tid >> 3, seg = tid & 7;
    constexpr int NWL = 133120;
    if (tid < 128) ((LAS float*)(lds + NWL))[tid] = nw[tid];
    for (int rp = 0; rp < REP_PROMPT; ++rp)
    for (int u = bid; u < 64; u += G) {
        const int b = u >> 3, h = u & 7;
        f32x4 St[8];
#pragma unroll
        for (int kt = 0; kt < 8; ++kt) St[kt] = (f32x4){0.f, 0.f, 0.f, 0.f};
        v4u pu[2], pw[2], pq[2], pk[2], pa, zc[2]; float gl_next, gl_cur;
#define GS_LOAD(nn) do { const bf16* cu = ch + (size_t)(u * 32 + (nn)) * CHU; \
            _Pragma("unroll") for (int r = 0; r < 2; ++r) { const int chunk = tid + 512 * r; pu[r] = *(const v4u*)(cu + OFF_U + chunk * 8); pw[r] = *(const v4u*)(cu + OFF_W + chunk * 8); \
                pq[r] = *(const v4u*)(cu + OFF_QG + chunk * 8); pk[r] = *(const v4u*)(cu + OFF_KDT + chunk * 8); } \
            pa = *(const v4u*)(cu + OFF_ATTN + tid * 8); \
            gl_next = glast[u * 32 + (nn)]; } while (0)
#define GS_STORE() do { \
            _Pragma("unroll") for (int r = 0; r < 2; ++r) { const int chunk = tid + 512 * r, row = chunk >> 4, cch = chunk & 15; \
                *(LAS v4u*)(lds + UL + row * 272 + cch * 16) = pu[r]; *(LAS v4u*)(lds + WL + row * 272 + cch * 16) = pw[r]; *(LAS v4u*)(lds + QGL + row * 272 + cch * 16) = pq[r]; \
                const int rowk = chunk >> 3, cck = chunk & 7; *(LAS v4u*)(lds + KDTL + rowk * 144 + cck * 16) = pk[r]; } \
            *(LAS v4u*)(lds + ATL + row8 * 144 + seg * 16) = pa; gl_cur = gl_next; } while (0)
        unsigned* flg = (unsigned*)(a.ws + WS_BAR + 16384) + j * 2048 + u * 32;
        if (wave == 0) { wait_flag_set(flg + 0, 0u); wait_flag_set(flg + 1, 0u); __builtin_amdgcn_fence(__ATOMIC_ACQUIRE, "agent"); asm volatile("s_waitcnt vmcnt(0)" ::: "memory"); }
        BAR_LDS();
        GS_LOAD(0);
        GS_STORE();
        for (int n = 0; n < 32; ++n) {
            unsigned fnext = 1u;
            if (wave == 0 && n + 2 < 32) fnext = __hip_atomic_load(flg + n + 2, RLX_AGENT_);
            { const bf16* zp = proj + (size_t)(b * SEQ + n * 64 + row8) * GINP + 3072 + h * 128 + seg * 16; zc[0] = *(const v4u*)zp; zc[1] = *(const v4u*)(zp + 8); }
            GS_LOAD(n + 1 < 32 ? n + 1 : 31);
#pragma unroll
            for (int kt = 0; kt < 8; ++kt) { v2u w2; w2.x = pk2(St[kt][0], St[kt][1]); w2.y = pk2(St[kt][2], St[kt][3]);
                *(LAS v2u*)(lds + SBL + (16 * wave + fr) * 272 + (kt * 16 + fq * 4) * 2) = w2; }
            BAR_LDS();
            bf16x8 bS[4];
#pragma unroll
            for (int kk = 0; kk < 4; ++kk) bS[kk] = *(const LAS bf16x8*)(lds + SBL + (16 * wave + fr) * 272 + (kk * 32 + fq * 8) * 2);
            f32x4 accQ[4];
#pragma unroll
            for (int ct = 0; ct < 4; ++ct) {
                f32x4 aw = {0.f, 0.f, 0.f, 0.f}, aq = {0.f, 0.f, 0.f, 0.f};
#pragma unroll
                for (int kk = 0; kk < 4; ++kk) { const bf16x8 fa = *(const LAS bf16x8*)(lds + WL + (ct * 16 + fr) * 272 + (kk * 32 + fq * 8) * 2); aw = MFMA16(fa, bS[kk], aw);
                    const bf16x8 fb = *(const LAS bf16x8*)(lds + QGL + (ct * 16 + fr) * 272 + (kk * 32 + fq * 8) * 2); aq = MFMA16(fb, bS[kk], aq); }
                float vn[4];
#pragma unroll
                for (int r = 0; r < 4; ++r) vn[r] = bf2f(*(const LAS unsigned short*)(lds + UL + (ct * 16 + fq * 4 + r) * 272 + (16 * wave + fr) * 2)) - aw[r];
                v2u w2; w2.x = pk2(vn[0], vn[1]); w2.y = pk2(vn[2], vn[3]);
                *(LAS v2u*)(lds + VNL + (16 * wave + fr) * 144 + (ct * 16 + fq * 4) * 2) = w2;
                accQ[ct] = aq;
            }
            LDS_WAIT();
            bf16x8 bV[2];
#pragma unroll
            for (int jj = 0; jj < 2; ++jj) bV[jj] = *(const LAS bf16x8*)(lds + VNL + (16 * wave + fr) * 144 + (jj * 32 + fq * 8) * 2);
#pragma unroll
            for (int ct = 0; ct < 4; ++ct)
#pragma unroll
                for (int jj = 0; jj < 2; ++jj) { const bf16x8 fa = *(const LAS bf16x8*)(lds + ATL + (ct * 16 + fr) * 144 + (jj * 32 + fq * 8) * 2); accQ[ct] = MFMA16(fa, bV[jj], accQ[ct]); }
#pragma unroll
            for (int kt = 0; kt < 8; ++kt) { St[kt] = St[kt] * gl_cur;
#pragma unroll
                for (int jj = 0; jj < 2; ++jj) { const bf16x8 fa = *(const LAS bf16x8*)(lds + KDTL + (kt * 16 + fr) * 144 + (jj * 32 + fq * 8) * 2); St[kt] = MFMA16(fa, bV[jj], St[kt]); } }
#pragma unroll
            for (int ct = 0; ct < 4; ++ct) { v2u w2; w2.x = pk2(accQ[ct][0], accQ[ct][1]); w2.y = pk2(accQ[ct][2], accQ[ct][3]);
                *(LAS v2u*)(lds + VNL + (16 * wave + fr) * 144 + (ct * 16 + fq * 4) * 2) = w2; }
            if (wave == 0 && n + 2 < 32) { wait_flag_set(flg + n + 2, fnext); __builtin_amdgcn_fence(__ATOMIC_ACQUIRE, "agent"); asm volatile("s_waitcnt vmcnt(0)" ::: "memory"); }
            BAR_LDS();
            GS_STORE();
            {   float ov[16]; float ss = 0.f;
#pragma unroll
                for (int e = 0; e < 16; ++e) { ov[e] = bf2f(*(const LAS unsigned short*)(lds + VNL + (seg * 16 + e) * 144 + row8 * 2)); ss += ov[e] * ov[e]; }
                ss += shx<1>(ss, lane); ss += shx<2>(ss, lane); ss += shx<4>(ss, lane);
                const float rstd = rsqrtf(ss * (1.f / 128.f) + EPS);
                v4u o2[2];
#pragma unroll
                for (int q = 0; q < 4; ++q) { const f32x4 wv = *(const LAS f32x4*)(lds + NWL + (seg * 16 + q * 4) * 4);
                    const unsigned z0 = zc[q >> 1][(q & 1) * 2], z1 = zc[q >> 1][(q & 1) * 2 + 1];
                    const float r0 = ov[4 * q] * rstd * wv.x * silu_f(bflo(z0)), r1 = ov[4 * q + 1] * rstd * wv.y * silu_f(bfhi(z0));
                    const float r2 = ov[4 * q + 2] * rstd * wv.z * silu_f(bflo(z1)), r3 = ov[4 * q + 3] * rstd * wv.w * silu_f(bfhi(z1));
                    o2[q >> 1][(q & 1) * 2] = pk2(r0, r1); o2[q >> 1][(q & 1) * 2 + 1] = pk2(r2, r3); }
                bf16* op = obuf + (size_t)(b * SEQ + n * 64 + row8) * 1024 + h * 128 + seg * 16;
                *(v4u*)op = o2[0]; *(v4u*)(op + 8) = o2[1];
            }
        }
        float* so = a.out + O_GSP + ((size_t)(j * 8 + b) * 8 + h) * 16384;
#pragma unroll
        for (int kt = 0; kt < 8; ++kt)
#pragma unroll
            for (int r = 0; r < 4; ++r) so[(kt * 16 + fq * 4 + r) * 128 + 16 * wave + fr] = St[kt][r];
        BAR_LDS();
    }
#undef GS_LOAD
#undef GS_STORE
    {
        int first, stride;
        if (G > 64) { first = bid - 64; stride = G - 64; } else { first = bid; stride = G; }
        const float* S0 = a.in[2] + (size_t)j * NSEQ_S * 8 * 16384;
        const bf16* qkv = (const bf16*)(a.ws + WS_QKV); const float* gb = (const float*)(a.ws + WS_GB);
        LAS float* qS = (LAS float*)lds;
        LAS float* kS = qS + 512; LAS float* vS = qS + 1024;
        LAS float* part = qS + 1536;
        LAS float* oS = part + 2048;
        LAS float* qkS = oS + 512;
        const int vq = tid & 31, kg = tid >> 5;
        if (first >= 0)
        for (int u = first; u < NSEQ_S * 8; u += stride) {
            const int b = u >> 3, h = u & 7; const int m0 = TP + 4 * b;
            f32x4 Sr[8];
            const float* sp = S0 + (size_t)u * 16384;
#pragma unroll
            for (int i = 0; i < 8; ++i) Sr[i] = *(const f32x4*)(sp + (kg * 8 + i) * 128 + vq * 4);
            for (int e = tid; e < 1536; e += 512) { const int tok = e / 384, rem = e - tok * 384, sect = rem >> 7, c = rem & 127;
                qS[sect * 512 + tok * 128 + c] = bf2f(qkv[(size_t)(m0 + tok) * CONVD + sect * 1024 + h * 128 + c]); }
            BAR_LDS();
            if (wave < 4) { const float d = qS[wave * 128 + lane] * kS[wave * 128 + lane] + qS[wave * 128 + 64 + lane] * kS[wave * 128 + 64 + lane]; const float s = wave_sum(lane, d); if (lane == 0) qkS[wave] = s; }
            BAR_LDS();
            for (int tok = 0; tok < 4; ++tok) {
                f32x4 pk4 = {0.f, 0.f, 0.f, 0.f}, pq4 = {0.f, 0.f, 0.f, 0.f};
#pragma unroll
                for (int i = 0; i < 8; ++i) { const float kv = kS[tok * 128 + kg * 8 + i], qv = qS[tok * 128 + kg * 8 + i]; pk4 += kv * Sr[i]; pq4 += qv * Sr[i]; }
#pragma unroll
                for (int e = 0; e < 4; ++e) { pk4[e] += shx<32>(pk4[e], lane); pq4[e] += shx<32>(pq4[e], lane); }
                if (lane < 32) { *(LAS f32x4*)(part + wave * 256 + vq * 4) = pk4; *(LAS f32x4*)(part + wave * 256 + 128 + vq * 4) = pq4; }
                BAR_LDS();
                f32x4 kSv = {0.f, 0.f, 0.f, 0.f}, qSv = {0.f, 0.f, 0.f, 0.f};
#pragma unroll
                for (int w = 0; w < 8; ++w) { kSv += *(const LAS f32x4*)(part + w * 256 + vq * 4); qSv += *(const LAS f32x4*)(part + w * 256 + 128 + vq * 4); }
                const float bt = gb[(size_t)(m0 + tok) * 16 + h], eg = __expf(gb[(size_t)(m0 + tok) * 16 + 8 + h]);
                const f32x4 vv = *(const LAS f32x4*)(vS + tok * 128 + vq * 4);
                const f32x4 dv4 = vv - eg * kSv;
                const f32x4 o4 = eg * qSv + (bt * qkS[tok]) * dv4;
#pragma unroll
                for (int i = 0; i < 8; ++i) { const float kv = kS[tok * 128 + kg * 8 + i]; Sr[i] = eg * Sr[i] + (bt * kv) * dv4; }
                if (tid < 32) *(LAS f32x4*)(oS + tok * 128 + vq * 4) = o4;
                BAR_LDS();
            }
            if (tid < 256) { const int tok = wave; const f32x2 o2 = *(const LAS f32x2*)(oS + tok * 128 + 2 * lane);
                const float ss = wave_sum(lane, o2.x * o2.x + o2.y * o2.y); const float rstd = rsqrtf(ss * (1.f / 128.f) + EPS);
                const unsigned zz = *(const unsigned*)(proj + (size_t)(m0 + tok) * GINP + 3072 + h * 128 + 2 * lane);
                const f32x2 wv = *(const f32x2*)(nw + 2 * lane);
                *(unsigned*)(obuf + (size_t)(m0 + tok) * 1024 + h * 128 + 2 * lane) = pk2(o2.x * rstd * wv.x * silu_f(bflo(zz)), o2.y * rstd * wv.y * silu_f(bfhi(zz))); }
            float* so = a.out + O_GSS + ((size_t)j * NSEQ_S * 8 + u) * 16384;
#pragma unroll
            for (int i = 0; i < 8; ++i) *(f32x4*)(so + (kg * 8 + i) * 128 + vq * 4) = Sr[i];
            BAR_LDS();
        }
    }
}

__device__ __forceinline__ void phase_ss(const Args& a, int j, LAS unsigned char* lds, int tid, int wave, int lane, int bid, int G) {
    constexpr int CL = 0, BLo = 17408, BTL = 34816, XSL = 53248, XDT = 62464, XWT = 71680, LLo = 80896, HBL = 90112, YL = 107520, ACL = 124928;
    const bf16* xbc = (const bf16*)(a.ws + WS_QKV); const float* dtb = (const float*)(a.ws + WS_GB);
    const bf16* proj = (const bf16*)(a.ws + WS_PROJ); bf16* obuf = (bf16*)(a.ws + WS_OBUF); float* ssq = (float*)(a.ws + WS_SSQ);
    const float* Alog = a.in[20] + j * 32; const float* Dsk = a.in[21] + j * 32;
    const int fr = lane & 15, fq = lane >> 4, row8 = tid >> 3, seg = tid & 7;
    LAS float* ACf = (LAS float*)(lds + ACL); LAS float* YLf = (LAS float*)(lds + YL);
    const int ptile = wave & 3, sg = wave >> 2;
    const float* H0 = a.in[4] + (size_t)j * NSEQ_S * 32 * 8192;
    LAS float* xsS = (LAS float*)(lds + 125440);
    LAS float* BS = xsS + 256;
    LAS float* CS = BS + 512;
    LAS float* yS = CS + 512;
    const int sq = tid & 7, pg = tid >> 3;
    f32x4 Hn[4]; unsigned short sgv[3]; float sdt[4]; unsigned short sz;
#define SSS_PREF(uu) do { const int u_ = (uu); const int b_ = u_ >> 5, h_ = u_ & 31, g_ = h_ >> 3; const int mm = TP + 4 * b_; \
        const float* hp = H0 + (size_t)u_ * 8192; \
        _Pragma("unroll") for (int i = 0; i < 4; ++i) Hn[i] = *(const f32x4*)(hp + pg * 128 + 16 * sq + 4 * i); \
        _Pragma("unroll") for (int k = 0; k < 3; ++k) { { const int e0 = tid + 512 * k; const int e = e0 < 1280 ? e0 : 1279; const int tok = e / 320, rem = e - tok * 320; \
            const int col = rem < 64 ? h_ * 64 + rem : (rem < 192 ? 2048 + g_ * 128 + rem - 64 : 2560 + g_ * 128 + rem - 192); sgv[k] = xbc[(size_t)(mm + tok) * CONVD + col]; } } \
        _Pragma("unroll") for (int k = 0; k < 4; ++k) sdt[k] = dtb[(size_t)(mm + k) * 32 + h_]; \
        sz = proj[(size_t)(mm + (tid >> 6 & 3)) * SINP + h_ * 64 + (tid & 63)]; } while (0)
    const bool inter = (G == 256);
    int su = bid;
    if (su < NSEQ_S * 32) SSS_PREF(su);
    for (int rp = 0; rp < REP_PROMPT; ++rp)
    for (int u0 = bid; u0 < 256; u0 += G) {
        int u = u0;
        if (G == 256) { const int x = u0 & 7, sl = u0 >> 3, pgi = x + 8 * (sl >> 3); u = (pgi >> 2) * 32 + (pgi & 3) * 8 + (sl & 7); }
        const int b = u >> 5, h = u & 31, g = h >> 3; const float Ah = -__expf(Alog[h]); const float Dh = Dsk[h];
        f32x4 Hs[4];
#pragma unroll
        for (int q = 0; q < 4; ++q) Hs[q] = (f32x4){0.f, 0.f, 0.f, 0.f};
        v4u px, pB[2], pC[2], zc; float pdt;
#define SS_LOAD(nn) do { const int m0_ = b * SEQ + (nn) * 64; \
            px = *(const v4u*)(xbc + (size_t)(m0_ + row8) * CONVD + h * 64 + seg * 8); \
            _Pragma("unroll") for (int r = 0; r < 2; ++r) { const int chunk = tid + 512 * r, row = chunk >> 4, cch = chunk & 15; \
                pB[r] = *(const v4u*)(xbc + (size_t)(m0_ + row) * CONVD + 2048 + g * 128 + cch * 8); pC[r] = *(const v4u*)(xbc + (size_t)(m0_ + row) * CONVD + 2560 + g * 128 + cch * 8); } \
            pdt = dtb[(size_t)(m0_ + lane) * 32 + h]; } while (0)
#define SS_FILL() do { const float Ac = wave_incl_scan(pdt * Ah, lane); const float Ac_r = shi(Ac, row8), dt_r = shi(pdt, row8), last_ = shi(Ac, 63); \
            if (wave == 0) ACf[lane] = Ac; \
            _Pragma("unroll") for (int r = 0; r < 2; ++r) { const int chunk = tid + 512 * r, row = chunk >> 4, cch = chunk & 15; \
                *(LAS v4u*)(lds + BLo + row * 272 + cch * 16) = pB[r]; *(LAS v4u*)(lds + CL + row * 272 + cch * 16) = pC[r]; \
                _Pragma("unroll") for (int e = 0; e < 4; ++e) { const unsigned wv = pB[r][e]; \
                    *(LAS unsigned short*)(lds + BTL + tsw_w(cch * 8 + 2 * e, row)) = (unsigned short)(wv & 0xffffu); \
                    *(LAS unsigned short*)(lds + BTL + tsw_w(cch * 8 + 2 * e + 1, row)) = (unsigned short)(wv >> 16); } } \
            *(LAS v4u*)(lds + XSL + row8 * 144 + seg * 16) = px; \
            const float wt_ = dt_r * __expf(last_ - Ac_r); \
            _Pragma("unroll") for (int e = 0; e < 4; ++e) { const float x0 = bflo(px[e]), x1 = bfhi(px[e]); \
                *(LAS unsigned short*)(lds + XDT + tsw_w(seg * 8 + 2 * e, row8)) = f2bf(x0 * dt_r); *(LAS unsigned short*)(lds + XDT + tsw_w(seg * 8 + 2 * e + 1, row8)) = f2bf(x1 * dt_r); \
                *(LAS unsigned short*)(lds + XWT + tsw_w(seg * 8 + 2 * e, row8)) = f2bf(x0 * wt_); *(LAS unsigned short*)(lds + XWT + tsw_w(seg * 8 + 2 * e + 1, row8)) = f2bf(x1 * wt_); } \
            } while (0)
        SS_LOAD(0);
        SS_FILL();
        for (int n = 0; n < 32; ++n) {
            const int m0 = b * SEQ + n * 64;
            zc = *(const v4u*)(proj + (size_t)(m0 + row8) * SINP + h * 64 + seg * 8);
            SS_LOAD(n + 1 < 32 ? n + 1 : 31);
            const bool sstep = inter && ((n & 1) == 0) && su < NSEQ_S * 32;
            const int sb_ = su >> 5, sh_ = su & 31; const int sm0 = TP + 4 * sb_;
            if (sstep) {
#pragma unroll
                for (int k = 0; k < 3; ++k) { const int e = tid + 512 * k; if (e < 1280) { const int tok = e / 320, rem = e - tok * 320; const float v = bf2f(sgv[k]);
                    if (rem < 64) xsS[tok * 64 + rem] = v; else if (rem < 192) BS[tok * 128 + rem - 64] = v; else CS[tok * 128 + rem - 192] = v; } }
            }
#pragma unroll
            for (int q = 0; q < 4; ++q) { const int stile = 4 * sg + q; v2u w2; w2.x = pk2(Hs[q][0], Hs[q][1]); w2.y = pk2(Hs[q][2], Hs[q][3]);
                *(LAS v2u*)(lds + HBL + (16 * ptile + fr) * 272 + (stile * 16 + fq * 4) * 2) = w2; }
            BAR_LDS();
            if (sstep) {
                const float sAh = -__expf(Alog[sh_]);
#pragma unroll
                for (int tok = 0; tok < 4; ++tok) {
                    const float dt = sdt[tok]; const float dA = __expf(dt * sAh);
                    const float dx = dt * xsS[tok * 64 + pg]; float y = 0.f;
#pragma unroll
                    for (int i = 0; i < 4; ++i) { const f32x4 B4 = *(const LAS f32x4*)(BS + tok * 128 + 16 * sq + 4 * i), C4 = *(const LAS f32x4*)(CS + tok * 128 + 16 * sq + 4 * i);
                        Hn[i] = dA * Hn[i] + dx * B4; y += (Hn[i].x * C4.x + Hn[i].y * C4.y) + (Hn[i].z * C4.z + Hn[i].w * C4.w); }
                    y += shx<1>(y, lane); y += shx<2>(y, lane); y += shx<4>(y, lane);
                    if (sq == 0) yS[tok * 64 + pg] = y;
                }
            }
#pragma unroll
            for (int tt = 0; tt < 2; ++tt) { const int id = 2 * wave + tt, tr = id >> 2, tc = id & 3; const int jcol = tc * 16 + fr;
                if (tc <= tr) {
                    f32x4 acc = {0.f, 0.f, 0.f, 0.f};
#pragma unroll
                    for (int kk = 0; kk < 4; ++kk) { const bf16x8 fa = *(const LAS bf16x8*)(lds + CL + (tr * 16 + fr) * 272 + (kk * 32 + fq * 8) * 2);
                        const bf16x8 fb = *(const LAS bf16x8*)(lds + BLo + (tc * 16 + fr) * 272 + (kk * 32 + fq * 8) * 2); acc = MFMA16(fa, fb, acc); }
                    const float Aj = ACf[jcol];
#pragma unroll
                    for (int r = 0; r < 4; ++r) { const int i = tr * 16 + fq * 4 + r; const float val = (i >= jcol) ? acc[r] * __expf(ACf[i] - Aj) : 0.f;
                        *(LAS unsigned short*)(lds + LLo + i * 144 + jcol * 2) = f2bf(val); }
                } else {
#pragma unroll
                    for (int r = 0; r < 4; ++r) { const int i = tr * 16 + fq * 4 + r; *(LAS unsigned short*)(lds + LLo + i * 144 + jcol * 2) = 0; }
                }
            }
            BAR_LDS();
            if (sstep) {
                if (tid < 256) { const int tok = wave, p = lane;
                    const float val = (yS[tok * 64 + p] + Dsk[sh_] * xsS[tok * 64 + p]) * silu_f(bf2f(sz));
                    const float ss = wave_sum(lane, val * val); if (lane == 0) ssq[(size_t)(sm0 + tok) * 32 + sh_] = ss;
                    obuf[(size_t)(sm0 + tok) * 2048 + sh_ * 64 + p] = f2bf(val); }
                float* sho = a.out + O_SHS + ((size_t)j * NSEQ_S * 32 + su) * 8192;
#pragma unroll
                for (int i = 0; i < 4; ++i) *(f32x4*)(sho + pg * 128 + 16 * sq + 4 * i) = Hn[i];
                su += G;
                SSS_PREF(su < NSEQ_S * 32 ? su : su - G);
            }
            const float last = ACf[63];
#pragma unroll
            for (int tt = 0; tt < 2; ++tt) { const int it = 2 * sg + tt;
                f32x4 acc = {0.f, 0.f, 0.f, 0.f};
#pragma unroll
                for (int kk = 0; kk < 4; ++kk) { const bf16x8 fa = *(const LAS bf16x8*)(lds + CL + (it * 16 + fr) * 272 + (kk * 32 + fq * 8) * 2);
                    const bf16x8 fb = *(const LAS bf16x8*)(lds + HBL + (16 * ptile + fr) * 272 + (kk * 32 + fq * 8) * 2); acc = MFMA16(fa, fb, acc); }
#pragma unroll
                for (int r = 0; r < 4; ++r) acc[r] *= __expf(ACf[it * 16 + fq * 4 + r]);
#pragma unroll
                for (int jj = 0; jj < 2; ++jj) { const bf16x8 fa = *(const LAS bf16x8*)(lds + LLo + (it * 16 + fr) * 144 + (jj * 32 + fq * 8) * 2);
                    const bf16x8 fb = *(const LAS bf16x8*)(lds + XDT + tsw_r(16 * ptile + fr, jj * 4 + fq)); acc = MFMA16(fa, fb, acc); }
#pragma unroll
                for (int r = 0; r < 4; ++r) YLf[(it * 16 + fq * 4 + r) * 68 + 16 * ptile + fr] = acc[r];
            }
            {   const float eL = __expf(last);
                bf16x8 bX[2];
#pragma unroll
                for (int jj = 0; jj < 2; ++jj) bX[jj] = *(const LAS bf16x8*)(lds + XWT + tsw_r(16 * ptile + fr, jj * 4 + fq));
#pragma unroll
                for (int q = 0; q < 4; ++q) { const int stile = 4 * sg + q; Hs[q] = Hs[q] * eL;
#pragma unroll
                    for (int jj = 0; jj < 2; ++jj) { const bf16x8 fa = *(const LAS bf16x8*)(lds + BTL + tsw_r(stile * 16 + fr, jj * 4 + fq)); Hs[q] = MFMA16(fa, bX[jj], Hs[q]); } }
            }
            BAR_LDS();
            {   const f32x4 y0 = *(const LAS f32x4*)(lds + YL + (row8 * 68 + seg * 8) * 4), y1 = *(const LAS f32x4*)(lds + YL + (row8 * 68 + seg * 8 + 4) * 4);
                const v4u xv = *(const LAS v4u*)(lds + XSL + row8 * 144 + seg * 16);
                float val[8]; float ss = 0.f;
#pragma unroll
                for (int e = 0; e < 4; ++e) { const float ya = e < 2 ? y0[2 * e] : y1[2 * e - 4], yb = e < 2 ? y0[2 * e + 1] : y1[2 * e - 3];
                    val[2 * e] = (ya + Dh * bflo(xv[e])) * silu_f(bflo(zc[e])); val[2 * e + 1] = (yb + Dh * bfhi(xv[e])) * silu_f(bfhi(zc[e]));
                    ss += val[2 * e] * val[2 * e] + val[2 * e + 1] * val[2 * e + 1]; }
                ss += shx<1>(ss, lane); ss += shx<2>(ss, lane); ss += shx<4>(ss, lane);
                if (seg == 0) ssq[(size_t)(m0 + row8) * 32 + h] = ss;
                v4u o; o.x = pk2(val[0], val[1]); o.y = pk2(val[2], val[3]); o.z = pk2(val[4], val[5]); o.w = pk2(val[6], val[7]);
                *(v4u*)(obuf + (size_t)(m0 + row8) * 2048 + h * 64 + seg * 8) = o;
            }
            BAR_LDS();
            SS_FILL();
        }
        float* ho = a.out + O_SHP + ((size_t)(j * 8 + b) * 32 + h) * 8192;
#pragma unroll
        for (int q = 0; q < 4; ++q) { const int stile = 4 * sg + q; *(f32x4*)(ho + (16 * ptile + fr) * 128 + stile * 16 + fq * 4) = Hs[q]; }
        BAR_LDS();
    }
#undef SS_LOAD
#undef SS_FILL
    {
        for (int u = su; u < NSEQ_S * 32; u += G) {
            const int b = u >> 5, h = u & 31; const int m0 = TP + 4 * b;
            const float Ah = -__expf(Alog[h]); const float Dh = Dsk[h];
            f32x4 Hr[4]; float dtc[4];
#pragma unroll
            for (int i = 0; i < 4; ++i) Hr[i] = Hn[i];
#pragma unroll
            for (int k = 0; k < 4; ++k) dtc[k] = sdt[k];
            const float zz = bf2f(sz);
#pragma unroll
            for (int k = 0; k < 3; ++k) { const int e = tid + 512 * k; if (e < 1280) { const int tok = e / 320, rem = e - tok * 320; const float v = bf2f(sgv[k]);
                if (rem < 64) xsS[tok * 64 + rem] = v; else if (rem < 192) BS[tok * 128 + rem - 64] = v; else CS[tok * 128 + rem - 192] = v; } }
            BAR_LDS();
            SSS_PREF(u + G < NSEQ_S * 32 ? u + G : u);
#pragma unroll
            for (int tok = 0; tok < 4; ++tok) {
                const float dt = dtc[tok]; const float dA = __expf(dt * Ah);
                const float dx = dt * xsS[tok * 64 + pg]; float y = 0.f;
#pragma unroll
                for (int i = 0; i < 4; ++i) { const f32x4 B4 = *(const LAS f32x4*)(BS + tok * 128 + 16 * sq + 4 * i), C4 = *(const LAS f32x4*)(CS + tok * 128 + 16 * sq + 4 * i);
                    Hr[i] = dA * Hr[i] + dx * B4; y += (Hr[i].x * C4.x + Hr[i].y * C4.y) + (Hr[i].z * C4.z + Hr[i].w * C4.w); }
                y += shx<1>(y, lane); y += shx<2>(y, lane); y += shx<4>(y, lane);
                if (sq == 0) yS[tok * 64 + pg] = y;
            }
            BAR_LDS();
            if (tid < 256) { const int tok = wave, p = lane;
                const float val = (yS[tok * 64 + p] + Dh * xsS[tok * 64 + p]) * silu_f(zz);
                const float ss = wave_sum(lane, val * val); if (lane == 0) ssq[(size_t)(m0 + tok) * 32 + h] = ss;
                obuf[(size_t)(m0 + tok) * 2048 + h * 64 + p] = f2bf(val); }
            float* ho = a.out + O_SHS + ((size_t)j * NSEQ_S * 32 + u) * 8192;
#pragma unroll
            for (int i = 0; i < 4; ++i) *(f32x4*)(ho + pg * 128 + 16 * sq + 4 * i) = Hr[i];
            BAR_LDS();
        }
#undef SSS_PREF
    }
}

constexpr int NSUB = 11, N_PHASES = 1 + 4 * NSUB;
#ifndef REP_SUBMASK
#define REP_LMASK 15
#define REP_SUBMASK 0
#endif
__host__ __device__ __forceinline__ bool phase_is_noop(int ph) { if (ph == 0) return false; const int L = (ph - 1) / NSUB, sub = (ph - 1) % NSUB; (void)L; return sub == 2 || sub == 6 || sub == 10; }

__global__ void __launch_bounds__(512, 2) fwd_kernel(Args a) {
    extern __shared__ __attribute__((aligned(16))) unsigned char lds_raw[];
    LAS unsigned char* lds = (LAS unsigned char*)lds_raw;
    cg::grid_group grid = cg::this_grid();
    if (a.ph_lo < 0) grid.sync();
    volatile LAS unsigned* bst = (volatile LAS unsigned*)(lds + LDS_BYTES - 16);
    if (threadIdx.x == 0) { bst[0] = 0u; bst[1] = 0u; }
    __syncthreads();
    const XcdBarrier gbar = xcd_barrier_post((unsigned*)(a.ws + WS_BAR), bst);
    for (int ph = a.ph_lo; ph < a.ph_hi; ++ph) {
        if (phase_is_noop(ph)) continue;
        int reps = 1;
        if (ph == 0) { if (REP_SUBMASK & 2048) reps = 2; } else if (((REP_SUBMASK >> ((ph - 1) % NSUB)) & 1) && ((REP_LMASK >> ((ph - 1) / NSUB)) & 1)) reps = 2;
        for (int rep = 0; rep < reps; ++rep) {
        int tid = threadIdx.x; asm volatile("" : "+v"(tid));
        int G = gridDim.x, bid = blockIdx.x; asm volatile("" : "+s"(G), "+s"(bid));
        const int lane = tid & 63, wave = __builtin_amdgcn_readfirstlane(tid >> 6);
        unsigned char* ws = a.ws; asm volatile("" : "+s"(ws));
        int cv_lo = 0, cv_hi = 0, cw_id = 0, cw_n = 1;
        if (ph == 0) { phase_prologue(a, lds, wave, lane, bid, G); cv_hi = CV_N0; cw_id = bid * 8 + wave; cw_n = G * 8; }
        else {
            const int L = (ph - 1) / NSUB, sub = (ph - 1) % NSUB, j = L >> 1; const bool isG = (L & 1) == 0;
            bool do_gemm = false, do_res = false;
            const bf16* gA = nullptr; const bf16* gB = nullptr; bf16* gO = nullptr; int gM = 0, gN = 0, gK = 0, gLD = 0, gC = bid;
            const bf16* r_g2 = nullptr;
            int r_lo = 0, r_hi = 0, r_gw = 0, r_ngw = 1; bool r_ffn = false;
            constexpr int NSB = 32;
            bf16* const gpart1 = (bf16*)(ws + WS_GOUT + 40 * MiB);
            bool g_wt = false; int r_np = 0;
            if (sub == 0) { do_gemm = true; gA = (const bf16*)(ws + WS_HN); gM = T; gK = DM; gLD = DM; gO = (bf16*)(ws + WS_PROJ);
                if (isG) { gN = GINP; gB = (const bf16*)(ws + WS_WGIN) + (size_t)j * GINP * DM; } else { gN = SINP; gB = (const bf16*)(ws + WS_WSIN) + (size_t)j * SINP * DM; } }
            else if (sub == 4 || sub == 5 || sub == 8 || sub == 9) {
                const bool dn = sub >= 8; const bool second = (sub == 5 || sub == 9);
                if (!second || bid < NSB) {
                    do_gemm = true; gN = DM;
                    if (!dn) { gA = (const bf16*)(ws + WS_OBUF); gK = isG ? 1024 : 2048; gB = isG ? (const bf16*)(ws + WS_WGOUT) + (size_t)j * DM * DM : (const bf16*)(ws + WS_WSOUT) + (size_t)j * DM * 2048; }
                    else { gA = (const bf16*)(ws + WS_ACT); gK = DFF; gB = (const bf16*)(ws + WS_WDN) + (size_t)L * DM * DFF; }
                    gO = (bf16*)(ws + WS_GOUT); gM = TP;
                    gLD = gK;
                    if (second) { gA += (size_t)TP * gK; gO += (size_t)TP * DM; gM = T - TP;
                        const int ks = bid >> 3, n128 = gK >> 7, k0 = ((ks * n128) >> 2) << 7, k1 = (((ks + 1) * n128) >> 2) << 7;
                        gC = bid & 7; gK = k1 - k0; gA += k0; gB += k0; if (ks) gO = gpart1 + (size_t)(ks - 1) * (T - TP) * DM; g_wt = true; }
                }
            }
            if (do_gemm) {
                pg8::Gemm g{gA, gB, gM, gN, gK, gLD};
                pg8::StaticOrder S; S.init(gM, gN, G, gC);
                pg8::EpiBf16 E{gO, gN, g_wt};
                pg8::gemm_phase<pg8::EpiBf16, pg8::StaticOrder, true, true>(lds, g, S, E);
            }
            if ((sub == 5 || sub == 9) && bid < NSB) {
                asm volatile("s_waitcnt vmcnt(0)" ::: "memory"); __syncthreads();
                if (tid == 0) { unsigned* cnt = (unsigned*)(ws + WS_BAR + 32768) + (L * 2 + (sub == 9 ? 1 : 0)) * 64;
                    __hip_atomic_fetch_add(cnt, 1u, RLX_AGENT_);
                    unsigned spins = 0; while (__hip_atomic_load(cnt, RLX_AGENT_) < (unsigned)NSB && spins < (1u << 22)) { __builtin_amdgcn_s_sleep(2); ++spins; }
                    __builtin_amdgcn_fence(__ATOMIC_ACQUIRE, "agent"); asm volatile("s_waitcnt vmcnt(0)" ::: "memory"); }
                __syncthreads();
            }
            if (sub == 5 || sub == 9) {
                do_res = true; r_ffn = sub == 9;
                if (bid >= NSB) { r_lo = 0; r_hi = TP; r_gw = (bid - NSB) * 8 + wave; r_ngw = (G - NSB) * 8; }
                else { r_lo = TP; r_hi = T; r_gw = bid * 8 + wave; r_ngw = NSB * 8; r_g2 = gpart1 - (size_t)TP * DM; r_np = 3; }
            }
            if (do_res) phase_res(a, L, r_ffn, r_lo, r_hi, r_gw, r_ngw, lane, r_g2, r_np);
            if (sub == 1) { if (isG) phase_conv<true>(a, j, wave, lane, bid, G); else phase_conv<false>(a, j, wave, lane, bid, G); }
            else if (sub == 3) { if (isG) { if (bid >= 64) phase_gp(a, j, lds, tid, wave, lane, bid, G); phase_gs(a, j, lds, tid, wave, lane, bid, G); } else phase_ss(a, j, lds, tid, wave, lane, bid, G); }
            else if (sub == 7) {
                pg8::Gemm g{(const bf16*)(ws + WS_HN), (const bf16*)(ws + WS_WGU) + (size_t)L * 2 * DFF * DM, T, 2 * DFF, DM, DM};
                pg8::StaticOrder S; S.init(T, 2 * DFF, G, bid);
                pg8::EpiSwiGLU E{(bf16*)(ws + WS_ACT), DFF};
                pg8::gemm_phase<pg8::EpiSwiGLU, pg8::StaticOrder, true, true>(lds, g, S, E);
            }
        }
        if (ph > 0) { const int sub_ = (ph - 1) % NSUB, L_ = (ph - 1) / NSUB;
            if (sub_ == 0 || sub_ == 7) {
                const int nN = sub_ == 7 ? (2 * DFF) / 256 : ((L_ & 1) ? SINP / 256 : GINP / 256); const int nwg = (T / 256) * nN, rounds = (nwg + G - 1) / G, c0 = nwg - (rounds - 1) * G, w = 2 * L_ + (sub_ == 7 ? 1 : 0);
                if (bid >= c0 && c0 < G) { cv_lo = CV_N0 + CV_WB(w); cv_hi = CV_N0 + CV_WB(w + 1); cw_id = (bid - c0) * 8 + wave; cw_n = (G - c0) * 8; } } }
        if (cv_hi > cv_lo) phase_convert(a, lds, cv_lo, cv_hi, cw_id, cw_n, wave, lane);
        }
        if (ph + 1 < a.ph_hi) { xcd_barrier(gbar); if (REP_BARRIER) xcd_barrier(gbar); }
    }
}

#ifndef MK_MULTI
#define MK_MULTI 0
#endif
extern "C" void kernel_launch(void* const* d_in, const int* in_sizes, int n_in, void* d_out, int out_size, void* d_ws, size_t ws_size, hipStream_t stream) {
    static int grid = 0;
    if (grid == 0) {
        if (n_in != 27 || (size_t)out_size != O_END || ws_size < WS_END) { fprintf(stderr, "kernel_launch: unexpected shapes n_in %d out %d ws %zu\n", n_in, out_size, ws_size); grid = -1; return; }
        int dev = 0, cus = 0, per_cu = 0;
        hipGetDevice(&dev); hipDeviceGetAttribute(&cus, hipDeviceAttributeMultiprocessorCount, dev);
        if (hipFuncSetAttribute((const void*)fwd_kernel, hipFuncAttributeMaxDynamicSharedMemorySize, LDS_BYTES) != hipSuccess) { fprintf(stderr, "kernel_launch: hipFuncSetAttribute failed\n"); grid = -1; return; }
        if (hipOccupancyMaxActiveBlocksPerMultiprocessor(&per_cu, (const void*)fwd_kernel, 512, LDS_BYTES) != hipSuccess || per_cu < 1) { fprintf(stderr, "kernel_launch: occupancy query gave %d\n", per_cu); per_cu = 1; }
        (void)hipGetLastError();
        grid = cus * (per_cu > 1 ? 1 : per_cu);
        if (grid <= 0) grid = 256;
        if (grid <= 64) { fprintf(stderr, "kernel_launch: this kernel needs more than 64 resident workgroups (got %d)\n", grid); grid = -1; return; }
    }
    if (grid < 0) return;
    if (hipMemsetAsync((char*)d_ws + WS_BAR, 0, 36864, stream) != hipSuccess) { fprintf(stderr, "kernel_launch: memset of barrier words failed\n"); return; }
    Args a{};
    for (int i = 0; i < 27; ++i) a.in[i] = (const float*)d_in[i];
    a.out = (float*)d_out; a.ws = (unsigned char*)d_ws;
#if MK_MULTI
    for (int ph = 0; ph < N_PHASES; ++ph) {
        if (phase_is_noop(ph)) continue;
        a.ph_lo = ph; a.ph_hi = ph + 1;
        void* args[] = {&a};
        hipError_t e = hipLaunchCooperativeKernel((const void*)fwd_kernel, dim3(grid), dim3(512), args, LDS_BYTES, stream);
        if (e != hipSuccess) { fprintf(stderr, "cooperative launch failed (phase %d): %s (grid %d)\n", ph, hipGetErrorString(e), grid); break; }
    }
#else
    a.ph_lo = 0; a.ph_hi = N_PHASES;
    void* args[] = {&a};
    hipError_t e = hipLaunchCooperativeKernel((const void*)fwd_kernel, dim3(grid), dim3(512), args, LDS_BYTES, stream);
    if (e != hipSuccess) fprintf(stderr, "cooperative launch failed: %s (grid %d)\n", hipGetErrorString(e), grid);
#endif
}
```

```cpp
#include <hip/hip_runtime.h>
#include <hip/hip_cooperative_groups.h>
#include <cstdio>
#include <cstdint>
namespace cg = cooperative_groups;
namespace pg8 {
#define PG8_LAS __attribute__((address_space(3)))
typedef unsigned short bf16_t;
typedef short bf16x8 __attribute__((ext_vector_type(8)));
typedef float f32x4 __attribute__((ext_vector_type(4)));
typedef unsigned u32x4 __attribute__((ext_vector_type(4)));
constexpr int BM = 256, BK = 64, HALF = 128, HTB = HALF * BK * 2  , STAGE_BYTES = 8 * HTB, NXCD = 8, WGM = 8;

__host__ __device__ __forceinline__ int lds_byte(int r, int c) { const int st = (r >> 4) * 2 + (c >> 5), rr = r & 15, cc = c & 31, ob = rr * 64 + cc * 2; return st * 1024 + (ob ^ (((ob >> 9) & 1) << 5)); }
__host__ __device__ __forceinline__ void stage_rc(int b, int& R, int& C) { const int st = b / 1024, sb = b % 1024, swz = sb ^ (((sb >> 9) & 1) << 5); R = (st >> 1) * 16 + swz / 64; C = (st & 1) * 32 + (swz % 64) / 2; }
__host__ __device__ __forceinline__ int perm32(int rho) { const int n = rho >> 4, i = rho & 15; return 8 * (i >> 2) + 4 * n + (i & 3); }

struct Unit { int pm, pn; };
struct Gemm { const bf16_t* A; const bf16_t* Bt; int M, N, K, ld; };

struct StaticOrder {
    int nM, nN, nwg, G, c;
    __host__ __device__ void init(int M, int N, int G_, int c_) { nM = M / BM; nN = N / BM; nwg = nM * nN; G = G_; c = c_; }
    __host__ __device__ bool next(int i, Unit& u) const {
        const long L = (long)i * G + c; if (L >= nwg) return false;
        int wgid = (int)L; { const int q = nwg / NXCD, r = nwg % NXCD, xcd = wgid % NXCD, off = wgid / NXCD; wgid = (xcd < r ? xcd * (q + 1) : r * (q + 1) + (xcd - r) * q) + off; }
        const int nig = WGM * nN, gid = wgid / nig, fm = gid * WGM, gsz = (nM - fm) < WGM ? (nM - fm) : WGM;
        u.pm = fm + ((wgid % nig) % gsz); u.pn = (wgid % nig) / gsz; return true;
    }
    __device__ __forceinline__ void a_ready(const Unit&) const {}
    __device__ __forceinline__ void done(const Unit&) const {}
};

__device__ __forceinline__ unsigned cvt_pk_bf16(float lo, float hi) { unsigned r; asm volatile("v_cvt_pk_bf16_f32 %0, %1, %2" : "=v"(r) : "v"(lo), "v"(hi)); return r; }
__device__ __forceinline__ float silu_f(float x) { return x * __builtin_amdgcn_rcpf(1.0f + __expf(-x)); }
struct EpiBf16 {
    static constexpr bool PERM = true, AFTER_DRAIN = false;
    bf16_t* O; int ldc; bool wt;
    __device__ __forceinline__ void operator()(const f32x4 (&acc)[2][2][4][2], const Unit& u, int wr, int wc, int fr, int fq) const {
        const int row0 = u.pm * BM + wr * 64 + fr; const int col0 = u.pn * BM + wc * 32 + 8 * fq;
#pragma unroll
        for (int ai = 0; ai < 2; ++ai)
#pragma unroll
            for (int m = 0; m < 4; ++m) { bf16_t* rowp = O + (size_t)(row0 + ai * HALF + m * 16) * ldc + col0;
#pragma unroll
                for (int bj = 0; bj < 2; ++bj) { const f32x4 v0 = acc[ai][bj][m][0], v1 = acc[ai][bj][m][1];
                    u32x4 w; w.x = cvt_pk_bf16(v0[0], v0[1]); w.y = cvt_pk_bf16(v0[2], v0[3]); w.z = cvt_pk_bf16(v1[0], v1[1]); w.w = cvt_pk_bf16(v1[2], v1[3]);
                    if (wt) asm volatile("global_store_dwordx4 %0, %1, off sc1\n\ts_nop 1" :: "v"(rowp + bj * HALF), "v"(w) : "memory");
                    else *(u32x4*)(rowp + bj * HALF) = w; } }
    }
};
struct EpiSwiGLU {
    static constexpr bool PERM = true, AFTER_DRAIN = false;
    bf16_t* O; int ldc;
    __device__ __forceinline__ void operator()(const f32x4 (&acc)[2][2][4][2], const Unit& u, int wr, int wc, int fr, int fq) const {
        const int row0 = u.pm * BM + wr * 64 + fr; const int col0 = u.pn * HALF + wc * 32 + 8 * fq;
#pragma unroll
        for (int ai = 0; ai < 2; ++ai)
#pragma unroll
            for (int m = 0; m < 4; ++m) { bf16_t* rowp = O + (size_t)(row0 + ai * HALF + m * 16) * ldc + col0;
                const f32x4 g0 = acc[ai][0][m][0], g1 = acc[ai][0][m][1], u0 = acc[ai][1][m][0], u1 = acc[ai][1][m][1];
                u32x4 w;
                w.x = cvt_pk_bf16(silu_f(g0[0]) * u0[0], silu_f(g0[1]) * u0[1]); w.y = cvt_pk_bf16(silu_f(g0[2]) * u0[2], silu_f(g0[3]) * u0[3]);
                w.z = cvt_pk_bf16(silu_f(g1[0]) * u1[0], silu_f(g1[1]) * u1[1]); w.w = cvt_pk_bf16(silu_f(g1[2]) * u1[2], silu_f(g1[3]) * u1[3]);
                *(u32x4*)rowp = w; }
    }
};
struct EpiF32 {
    static constexpr bool PERM = false, AFTER_DRAIN = false;
    float* O; int ldc;
    __device__ __forceinline__ void operator()(const f32x4 (&acc)[2][2][4][2], const Unit& u, int wr, int wc, int fr, int fq) const {
        const int row0 = u.pm * BM + wr * 64 + fr; const int col0 = u.pn * BM + wc * 32 + 4 * fq;
#pragma unroll
        for (int ai = 0; ai < 2; ++ai)
#pragma unroll
            for (int m = 0; m < 4; ++m) { float* rowp = O + (size_t)(row0 + ai * HALF + m * 16) * ldc + col0;
#pragma unroll
                for (int bj = 0; bj < 2; ++bj)
#pragma unroll
                    for (int n = 0; n < 2; ++n) *(f32x4*)(rowp + bj * HALF + n * 16) = acc[ai][bj][m][n]; }
    }
};
template <class Epi, class Sched, bool ALIGN_EPI = false, bool SP2 = false>
__device__ __forceinline__ void gemm_phase(PG8_LAS unsigned char* lds, const Gemm g, const Sched& S, const Epi& E) {
    int tid_l = threadIdx.x; asm volatile("" : "+v"(tid_l));
    const int tid = tid_l, wid = __builtin_amdgcn_readfirstlane(tid >> 6), lane = tid & 63, wr = wid >> 2, wc = wid & 3, fr = lane & 15, fq = lane >> 4;
    const int K = g.K, nt = K / BK, LD = g.ld;
    unsigned voffA[2], voffB[2];
#pragma unroll
    for (int i = 0; i < 2; ++i) { int R, C; stage_rc(tid * 16 + i * 8192, R, C); const int Rb = Epi::PERM ? ((R & ~31) + perm32(R & 31)) : R;
        voffA[i] = (unsigned)(R * LD + C) * 2u; voffB[i] = (unsigned)(Rb * LD + C) * 2u; }
    const size_t kstep = (size_t)(BK * 2);
    const size_t hstep = (size_t)HALF * LD * 2;
    const size_t tstep = 2 * hstep;
    const unsigned ldsw = (unsigned)wid * 1024u;
    const int aoff = lds_byte(wr * 64 + fr, fq * 8), boff = lds_byte(wc * 32 + fr, fq * 8);
#define PG8_SA(b, h) (((b) * 2 + (h)) * HTB)
#define PG8_SB(b, h) ((4 + (b) * 2 + (h)) * HTB)
#define PG8_STAGE(bufoff, gbase, voff) do { _Pragma("unroll") for (int _i = 0; _i < 2; ++_i) \
        __builtin_amdgcn_global_load_lds((const unsigned*)((const char*)(gbase) + (voff)[_i]), (PG8_LAS unsigned*)(lds + (bufoff) + ldsw + _i * 8192), 16, 0, 0); } while (0)
#define PG8_LDA(dst, b, h) do { _Pragma("unroll") for (int m = 0; m < 4; ++m) _Pragma("unroll") for (int k = 0; k < 2; ++k) dst[m][k] = *(const PG8_LAS bf16x8*)(lds + PG8_SA(b, h) + aoff + m * 2048 + k * 1024); } while (0)
#define PG8_LDB(dst, b, h) do { _Pragma("unroll") for (int n = 0; n < 2; ++n) _Pragma("unroll") for (int k = 0; k < 2; ++k) dst[n][k] = *(const PG8_LAS bf16x8*)(lds + PG8_SB(b, h) + boff + n * 2048 + k * 1024); } while (0)
#define PG8_MMA(ai, bj, At, Bt) do { __builtin_amdgcn_s_setprio(1); _Pragma("unroll") for (int m = 0; m < 4; ++m) _Pragma("unroll") for (int n = 0; n < 2; ++n) _Pragma("unroll") for (int k = 0; k < 2; ++k) \
        acc[ai][bj][m][n] = __builtin_amdgcn_mfma_f32_16x16x32_bf16(Bt[n][k], At[m][k], acc[ai][bj][m][n], 0, 0, 0); __builtin_amdgcn_s_setprio(0); } while (0)
#define PG8_WAIT_V(n) asm volatile("s_waitcnt vmcnt(" #n ")" ::: "memory")
#define PG8_WAIT_L(n) asm volatile("s_waitcnt lgkmcnt(" #n ")" ::: "memory")
#define PG8_BAR __builtin_amdgcn_s_barrier()
#define PG8_SCHED __builtin_amdgcn_sched_barrier(0)
    Unit cur, nxt; int ui = 0;
    if (!S.next(0, cur)) return;
    f32x4 acc[2][2][4][2];
#pragma unroll
    for (int a = 0; a < 2; ++a)
#pragma unroll
        for (int b = 0; b < 2; ++b)
#pragma unroll
            for (int m = 0; m < 4; ++m)
#pragma unroll
                for (int n = 0; n < 2; ++n) acc[a][b][m][n] = (f32x4){0.f, 0.f, 0.f, 0.f};
    bf16x8 At[4][2], B0[2][2], B1[2][2];
    const char* cA = (const char*)g.A + (size_t)cur.pm * tstep; const char* cB = (const char*)g.Bt + (size_t)cur.pn * tstep;
    S.a_ready(cur);
    if constexpr (SP2) {
        PG8_STAGE(PG8_SB(0, 0), cB, voffB); PG8_STAGE(PG8_SB(0, 1), cB + hstep, voffB); PG8_STAGE(PG8_SA(0, 0), cA, voffA); PG8_STAGE(PG8_SA(0, 1), cA + hstep, voffA);
        if (wr == 1) PG8_BAR;
        PG8_WAIT_V(2); PG8_BAR;
        PG8_STAGE(PG8_SB(1, 0), cB + kstep, voffB); PG8_STAGE(PG8_SA(1, 0), cA + kstep, voffA); PG8_STAGE(PG8_SB(1, 1), cB + hstep + kstep, voffB);
        PG8_WAIT_V(6); PG8_BAR;
    } else {
        PG8_STAGE(PG8_SB(0, 0), cB, voffB); PG8_STAGE(PG8_SA(0, 0), cA, voffA); PG8_STAGE(PG8_SB(0, 1), cB + hstep, voffB); PG8_STAGE(PG8_SA(0, 1), cA + hstep, voffA);
        if (wr == 1) PG8_BAR;
        PG8_WAIT_V(4); PG8_BAR;
        PG8_STAGE(PG8_SB(1, 0), cB + kstep, voffB); PG8_STAGE(PG8_SA(1, 0), cA + kstep, voffA); PG8_STAGE(PG8_SB(1, 1), cB + hstep + kstep, voffB);
        PG8_WAIT_V(6); PG8_BAR;
    }
    for (;;) {
        const bool has_next = S.next(ui + 1, nxt);
        const char* nA = has_next ? (const char*)g.A + (size_t)nxt.pm * tstep : cA; const char* nB = has_next ? (const char*)g.Bt + (size_t)nxt.pn * tstep : cB;
        for (int t = 0; t < nt; t += 2) {
            const bool last = (t == nt - 2);
            const char* a1 = cA + (size_t)(t + 1) * kstep;
            const char* a2 = last ? nA : cA + (size_t)(t + 2) * kstep; const char* b2 = last ? nB : cB + (size_t)(t + 2) * kstep;
            const char* a3 = a2 + kstep; const char* b3 = b2 + kstep;
            if (last && has_next) S.a_ready(nxt);
            if constexpr (SP2) {
            PG8_LDB(B0, 0, 0); PG8_LDB(B1, 0, 1); PG8_SCHED; PG8_LDA(At, 0, 0); PG8_STAGE(PG8_SA(1, 1), a1 + hstep, voffA);
            PG8_WAIT_V(8); PG8_WAIT_L(0); PG8_BAR; PG8_MMA(0, 0, At, B0); PG8_MMA(0, 1, At, B1); PG8_BAR; PG8_SCHED;
            PG8_LDA(At, 0, 1); PG8_STAGE(PG8_SB(0, 0), b2, voffB); PG8_STAGE(PG8_SB(0, 1), b2 + hstep, voffB); PG8_STAGE(PG8_SA(0, 0), a2, voffA);
            PG8_WAIT_V(8); PG8_WAIT_L(0); PG8_BAR; PG8_MMA(1, 0, At, B0); PG8_MMA(1, 1, At, B1); PG8_BAR; PG8_SCHED;
            PG8_LDB(B0, 1, 0); PG8_LDB(B1, 1, 1); PG8_SCHED; PG8_LDA(At, 1, 0); PG8_STAGE(PG8_SA(0, 1), a2 + hstep, voffA);
            PG8_WAIT_V(8); PG8_WAIT_L(0); PG8_BAR; PG8_MMA(0, 0, At, B0); PG8_MMA(0, 1, At, B1); PG8_BAR; PG8_SCHED;
            PG8_LDA(At, 1, 1); PG8_STAGE(PG8_SB(1, 0), b3, voffB); PG8_STAGE(PG8_SB(1, 1), b3 + hstep, voffB); PG8_STAGE(PG8_SA(1, 0), a3, voffA);
            PG8_WAIT_V(8); PG8_WAIT_L(0); PG8_BAR; PG8_MMA(1, 0, At, B0); PG8_MMA(1, 1, At, B1); PG8_BAR; PG8_SCHED;
            } else {
            PG8_LDB(B0, 0, 0); PG8_SCHED; PG8_LDA(At, 0, 0); PG8_STAGE(PG8_SA(1, 1), a1 + hstep, voffA);
            PG8_WAIT_L(8); PG8_BAR; PG8_WAIT_L(0); PG8_MMA(0, 0, At, B0); PG8_BAR; PG8_SCHED;
            PG8_LDB(B1, 0, 1); PG8_STAGE(PG8_SB(0, 0), b2, voffB);
            PG8_BAR; PG8_WAIT_L(0); PG8_MMA(0, 1, At, B1); PG8_BAR;
            PG8_LDA(At, 0, 1); PG8_STAGE(PG8_SA(0, 0), a2, voffA);
            PG8_BAR; PG8_WAIT_L(0); PG8_MMA(1, 0, At, B0); PG8_BAR; PG8_SCHED;
            PG8_STAGE(PG8_SB(0, 1), b2 + hstep, voffB);
            PG8_WAIT_V(6); PG8_BAR; PG8_MMA(1, 1, At, B1); PG8_BAR;
            PG8_LDB(B0, 1, 0); PG8_SCHED; PG8_LDA(At, 1, 0); PG8_STAGE(PG8_SA(0, 1), a2 + hstep, voffA);
            PG8_WAIT_L(8); PG8_BAR; PG8_WAIT_L(0); PG8_MMA(0, 0, At, B0); PG8_BAR; PG8_SCHED;
            PG8_LDB(B1, 1, 1); PG8_STAGE(PG8_SB(1, 0), b3, voffB);
            PG8_BAR; PG8_WAIT_L(0); PG8_MMA(0, 1, At, B1); PG8_BAR;
            PG8_LDA(At, 1, 1); PG8_STAGE(PG8_SA(1, 0), a3, voffA);
            PG8_BAR; PG8_WAIT_L(0); PG8_MMA(1, 0, At, B0); PG8_BAR; PG8_SCHED;
            PG8_STAGE(PG8_SB(1, 1), b3 + hstep, voffB);
            PG8_WAIT_V(6); PG8_BAR; PG8_MMA(1, 1, At, B1); PG8_BAR;
            }
        }
        if constexpr (ALIGN_EPI) { if (wr == 0) PG8_BAR; }
        if constexpr (!Epi::AFTER_DRAIN) { E(acc, cur, wr, wc, fr, fq); S.done(cur); }
        if (!has_next) break;
#pragma unroll
        for (int a = 0; a < 2; ++a)
#pragma unroll
            for (int b = 0; b < 2; ++b)
#pragma unroll
                for (int m = 0; m < 4; ++m)
#pragma unroll
                    for (int n = 0; n < 2; ++n) acc[a][b][m][n] = (f32x4){0.f, 0.f, 0.f, 0.f};
        cur = nxt; cA = nA; cB = nB; ++ui;
        if constexpr (ALIGN_EPI) { if (wr == 1) PG8_BAR; }
    }
    PG8_WAIT_V(0);
    if constexpr (!ALIGN_EPI) { if (wr == 0) PG8_BAR; }
    PG8_BAR;
    if constexpr (Epi::AFTER_DRAIN) { E.fused(acc, cur, wr, wc, fr, fq, lds, wid, lane); S.done(cur); }
#undef PG8_SA
#undef PG8_SB
#undef PG8_STAGE
#undef PG8_LDA
#undef PG8_LDB
#undef PG8_MMA
#undef PG8_WAIT_V
#undef PG8_WAIT_L
#undef PG8_BAR
#undef PG8_SCHED
}
}

#define LAS __attribute__((address_space(3)))
typedef unsigned short bf16;
typedef unsigned v4u __attribute__((ext_vector_type(4)));
typedef unsigned v2u __attribute__((ext_vector_type(2)));
typedef float f32x4 __attribute__((ext_vector_type(4)));
typedef float f32x2 __attribute__((ext_vector_type(2)));
typedef short bf16x8 __attribute__((ext_vector_type(8)));

constexpr int T = 16896, TP = 16384, DM = 1024, NSEQ_P = 8, SEQ = 2048, NSEQ_S = 128;
constexpr int GIN = 4112, GINP = 4352, SIN = 5152, SINP = 5376, DFF = 2816, CONVD = 3072;
constexpr float EPS = 1e-6f;
constexpr int LDS_BYTES = 147456;
constexpr size_t MiB = 1u << 20;
constexpr size_t WS_WGIN = 0, WS_WGOUT = 17 * MiB, WS_WSIN = 21 * MiB, WS_WSOUT = 42 * MiB, WS_WGU = 50 * MiB, WS_WDN = 94 * MiB, WS_HN = 116 * MiB,
                 WS_PROJ = 149 * MiB, WS_ACT = WS_PROJ, WS_QKV = 323 * MiB, WS_GB = 422 * MiB, WS_CH = 425 * MiB, WS_GLAST = 569 * MiB, WS_OBUF = 570 * MiB,
                 WS_SSQ = 636 * MiB, WS_GOUT = 639 * MiB, WS_BAR = 705 * MiB, WS_END = 706 * MiB;
constexpr size_t O_Y = 0, O_GSP = (size_t)T * DM, O_GCP = O_GSP + 2ull * 8 * 8 * 128 * 128, O_SHP = O_GCP + 2ull * 8 * 3 * CONVD, O_SCP = O_SHP + 2ull * 8 * 32 * 64 * 128,
                 O_GSS = O_SCP + 2ull * 8 * 3 * CONVD, O_GCS = O_GSS + 2ull * 128 * 8 * 128 * 128, O_SHS = O_GCS + 2ull * 128 * 3 * CONVD, O_SCS = O_SHS + 2ull * 128 * 32 * 64 * 128,
                 O_END = O_SCS + 2ull * 128 * 3 * CONVD;
static_assert(O_END == 129269760ull, "output size");
constexpr int OFF_U = 0, OFF_W = 8192, OFF_QG = 16384, OFF_KDT = 24576, OFF_ATTN = 32768, CHU = 36864;

struct Args { const float* in[27]; float* out; unsigned char* ws; int ph_lo, ph_hi; };

__device__ __forceinline__ float bf2f(unsigned short h) { return __uint_as_float((unsigned)h << 16); }
__device__ __forceinline__ float bflo(unsigned u) { return __uint_as_float(u << 16); }
__device__ __forceinline__ float bfhi(unsigned u) { return __uint_as_float(u & 0xffff0000u); }
__device__ __forceinline__ unsigned pk2(float lo, float hi) { return pg8::cvt_pk_bf16(lo, hi); }
__device__ __forceinline__ unsigned short f2bf(float f) { return (unsigned short)(pg8::cvt_pk_bf16(f, 0.f) & 0xffffu); }
__device__ __forceinline__ float silu_f(float x) { return x * __builtin_amdgcn_rcpf(1.0f + __expf(-x)); }
__device__ __forceinline__ float sigmoid_f(float x) { return __builtin_amdgcn_rcpf(1.0f + __expf(-x)); }
__device__ __forceinline__ float softplus_f(float x) { return fmaxf(x, 0.f) + log1pf(__expf(-fabsf(x))); }
template <int M> __device__ __forceinline__ float shx(float v, int lane) {
    if constexpr (M == 1) return __int_as_float(__builtin_amdgcn_update_dpp(0, __float_as_int(v), 0xB1, 0xf, 0xf, true));
    else if constexpr (M == 2) return __int_as_float(__builtin_amdgcn_update_dpp(0, __float_as_int(v), 0x4E, 0xf, 0xf, true));
    else if constexpr (M == 4) return __int_as_float(__builtin_amdgcn_update_dpp(0, __float_as_int(v), 0x141, 0xf, 0xf, true));
    else if constexpr (M == 8) return __int_as_float(__builtin_amdgcn_update_dpp(0, __float_as_int(v), 0x140, 0xf, 0xf, true));
    else if constexpr (M < 32) return __int_as_float(__builtin_amdgcn_ds_swizzle(__float_as_int(v), (M << 10) | 0x1f));
    else return __int_as_float(__builtin_amdgcn_ds_bpermute((lane ^ 32) << 2, __float_as_int(v)));
}
__device__ __forceinline__ float shi(float v, int src) { return __int_as_float(__builtin_amdgcn_ds_bpermute(src << 2, __float_as_int(v))); }
__device__ __forceinline__ float wave_sum(int lane, float v) {
    v += shx<1>(v, lane); v += shx<2>(v, lane); v += shx<4>(v, lane); v += shx<8>(v, lane);
    const float r0 = __int_as_float(__builtin_amdgcn_readlane(__float_as_int(v), 0)), r1 = __int_as_float(__builtin_amdgcn_readlane(__float_as_int(v), 16));
    const float r2 = __int_as_float(__builtin_amdgcn_readlane(__float_as_int(v), 32)), r3 = __int_as_float(__builtin_amdgcn_readlane(__float_as_int(v), 48));
    return (r0 + r1) + (r2 + r3);
}
__device__ __forceinline__ float wave_incl_scan(float v, int lane) {
#pragma unroll
    for (int d = 1; d < 64; d <<= 1) { const float t = shi(v, lane - d); if (lane >= d) v += t; }
    return v;
}
#define REP_BARRIER 0
#ifndef REP_PROMPT
#define REP_PROMPT 1
#endif
__device__ __forceinline__ int tsw_w(int row, int j) { return row * 144 + ((((j >> 3) ^ (row >> 3)) & 7) << 4) + ((j & 7) << 1); }
__device__ __forceinline__ int tsw_r(int row, int gran) { return row * 144 + (((gran ^ (row >> 3)) & 7) << 4); }
__device__ __forceinline__ void st16_wt(void* p, v4u v) { asm volatile("global_store_dwordx4 %0, %1, off sc1\n\ts_nop 1" :: "v"(p), "v"(v) : "memory"); }
#define RLX_AGENT_ __ATOMIC_RELAXED, __HIP_MEMORY_SCOPE_AGENT
__device__ __forceinline__ void wait_flag_set(unsigned* flag, unsigned seen) {
    unsigned v = seen, spins = 0;
    while (__builtin_amdgcn_readfirstlane(v) == 0u && spins < (1u << 22)) { __builtin_amdgcn_s_sleep(2); v = __hip_atomic_load(flag, RLX_AGENT_); ++spins; }
}
#define MFMA16(a, b, c) __builtin_amdgcn_mfma_f32_16x16x32_bf16((a), (b), (c), 0, 0, 0)
#define LDS_WAIT() asm volatile("s_waitcnt lgkmcnt(0)" ::: "memory")
#define BAR_LDS() do { asm volatile("s_waitcnt lgkmcnt(0)" ::: "memory"); __builtin_amdgcn_s_barrier(); asm volatile("" ::: "memory"); } while (0)

#define XB_TMO      128
#define XB_XCNT(j)  (256  + 64 * (j))
#define XB_XSUB(j)  (1280 + 64 * (j))
#define XB_XGEN(j)  (2304 + 64 * (j))
#define XB_TOP      3328
#define XB_TOPGEN   3392
#define XCD_BAR_WORDS 3456
#define XB_SPIN_CAP (1u << 18)

__device__ __forceinline__ unsigned xb_ld(unsigned* p)              { return __hip_atomic_load(p, __ATOMIC_RELAXED, __HIP_MEMORY_SCOPE_AGENT); }
__device__ __forceinline__ unsigned xb_add(unsigned* p, unsigned v) { return __hip_atomic_fetch_add(p, v, __ATOMIC_RELAXED, __HIP_MEMORY_SCOPE_AGENT); }
__device__ __forceinline__ unsigned xb_xcc_id() { return (unsigned)__builtin_amdgcn_s_getreg((3 << 11) | 20) & 0xFu; }
#define XB_SPIN(cond, bar) do { unsigned _sp = 0; while (cond) { __builtin_amdgcn_s_sleep(1); \
    if ((++_sp & 255u) == 0u) { if (xb_ld(&(bar)[XB_TMO])) break; if (_sp > XB_SPIN_CAP) { atomicAdd(&(bar)[XB_TMO], 1u); break; } } } } while (0)

struct XcdBarrier {
    unsigned* bar; unsigned x;
    volatile LAS unsigned* st;
};

__device__ __forceinline__ XcdBarrier xcd_barrier_post(unsigned* bar, volatile LAS unsigned* st) {
    XcdBarrier b; b.bar = bar; b.x = xb_xcc_id(); b.st = st;
    if (threadIdx.x == 0) (void)xb_add(&bar[XB_XCNT(b.x)], 1u);
    return b;
}
__device__ __forceinline__ void xcd_barrier_complete(unsigned* bar, unsigned x, unsigned& nloc, unsigned& nx) {
    const unsigned G = gridDim.x * gridDim.y * gridDim.z;
    unsigned sum, cnt, mine, sp = 0u;
    for (;;) {
        sum = 0u; cnt = 0u; mine = 0u;
#pragma unroll
        for (unsigned j = 0; j < 16; ++j) { const unsigned c = xb_ld(&bar[XB_XCNT(j)]); sum += c; cnt += (c > 0u) ? 1u : 0u; mine = (j == x) ? c : mine; }
        if (sum == G) break;
        __builtin_amdgcn_s_sleep(1);
        if ((++sp & 255u) == 0u) { if (xb_ld(&bar[XB_TMO])) break; if (sp > XB_SPIN_CAP) { atomicAdd(&bar[XB_TMO], 1u); break; } }
    }
    nloc = mine > 0u ? mine : 1u; nx = cnt > 0u ? cnt : 1u;
}

__device__ __forceinline__ void xcd_barrier(const XcdBarrier& b) {
    asm volatile("s_waitcnt vmcnt(0)" ::: "memory");
    __syncthreads();
    if (threadIdx.x == 0) {
        unsigned* bar = b.bar;
        __builtin_amdgcn_s_waitcnt(0);
        unsigned nloc = b.st[0], nx = b.st[1];
        if (nloc == 0u) { xcd_barrier_complete(bar, b.x, nloc, nx); b.st[0] = nloc; b.st[1] = nx; }
        const unsigned old = xb_add(&bar[XB_XSUB(b.x)], 1u);
        const unsigned gen = old / nloc;
        if (old + 1u == (gen + 1u) * nloc) {
            __builtin_amdgcn_fence(__ATOMIC_RELEASE, "agent");
            asm volatile("s_waitcnt vmcnt(0)" ::: "memory");
            const unsigned og = xb_add(&bar[XB_TOP], 1u);
            const unsigned tg = og / nx;
            if (og + 1u == (tg + 1u) * nx) xb_add(&bar[XB_TOPGEN], 1u);
            else XB_SPIN(xb_ld(&bar[XB_TOPGEN]) == tg, bar);
            __builtin_amdgcn_fence(__ATOMIC_ACQUIRE, "agent");
            xb_add(&bar[XB_XGEN(b.x)], 1u);
            asm volatile("s_waitcnt vmcnt(0)" ::: "memory");
        } else {
            XB_SPIN(xb_ld(&bar[XB_XGEN(b.x)]) == gen, bar);
            __builtin_amdgcn_fence(__ATOMIC_ACQUIRE, "agent");
            asm volatile("s_waitcnt vmcnt(0)" ::: "memory");
        }
    }
    __syncthreads();
}


__device__ __forceinline__ void tr_item(const float* __restrict__ W, int K, int N, bf16* WT, const float* __restrict__ ks, int mode, LAS float* scr, int item, int nblk, int lane) {
    const int kb = item / nblk, nb = item - kb * nblk, k0 = 64 * kb, n0 = 64 * nb;
    const int nn = n0 + 4 * (lane & 15); const bool ok = nn < N;
    f32x4 v[16];
#pragma unroll
    for (int i = 0; i < 16; ++i) { const int kk = 4 * i + (lane >> 4); v[i] = ok ? *(const f32x4*)(W + (size_t)(k0 + kk) * N + nn) : (f32x4){0.f, 0.f, 0.f, 0.f}; }
    if (ks) {
#pragma unroll
        for (int i = 0; i < 16; ++i) v[i] = v[i] * ks[k0 + 4 * i + (lane >> 4)];
    }
#pragma unroll
    for (int i = 0; i < 16; ++i) { const int kk = 4 * i + (lane >> 4); LAS float* d = scr + kk * 65 + 4 * (lane & 15); d[0] = v[i].x; d[1] = v[i].y; d[2] = v[i].z; d[3] = v[i].w; }
    LDS_WAIT();
    const int c = lane & 7;
#pragma unroll
    for (int jx = 0; jx < 8; ++jx) { const int n = (lane >> 3) + 8 * jx; const LAS float* sp = scr + (8 * c) * 65 + n;
        v4u o; o.x = pk2(sp[0 * 65], sp[1 * 65]); o.y = pk2(sp[2 * 65], sp[3 * 65]); o.z = pk2(sp[4 * 65], sp[5 * 65]); o.w = pk2(sp[6 * 65], sp[7 * 65]);
        const int nr = n0 + n; const int dr = mode == 0 ? nr : (((nr >> 7) << 8) + (nr & 127) + (mode == 2 ? 128 : 0));
        *(v4u*)(WT + (size_t)dr * K + k0 + 8 * c) = o; }
    LDS_WAIT();
}
constexpr int I_GIN = 16 * (GINP / 64), I_GOUT = 16 * 16, I_SIN = 16 * (SINP / 64), I_SOUT = 32 * 16, I_GU = 16 * (DFF / 64), I_DN = (DFF / 64) * 16;
constexpr int O_GIN = 0, O_GOUT = 2 * I_GIN, O_SIN = O_GOUT + 2 * I_GOUT, O_SOUT = O_SIN + 2 * I_SIN, O_GU = O_SOUT + 2 * I_SOUT, O_DN = O_GU + 8 * I_GU;
__device__ __forceinline__ void cvt_item(const Args& a, LAS float* scr, int it, int lane) {
    unsigned char* ws = a.ws; int r = it;
    if (r < 2 * I_GIN) { const int j = r / I_GIN; r -= j * I_GIN; tr_item(a.in[10] + (size_t)j * DM * GIN, DM, GIN, (bf16*)(ws + WS_WGIN) + (size_t)j * GINP * DM, a.in[6] + (2 * j) * DM, 0, scr, r, GINP / 64, lane); return; }
    r -= 2 * I_GIN;
    if (r < 2 * I_GOUT) { const int j = r / I_GOUT; r -= j * I_GOUT; tr_item(a.in[15] + (size_t)j * DM * DM, DM, DM, (bf16*)(ws + WS_WGOUT) + (size_t)j * DM * DM, nullptr, 0, scr, r, DM / 64, lane); return; }
    r -= 2 * I_GOUT;
    if (r < 2 * I_SIN) { const int j = r / I_SIN; r -= j * I_SIN; tr_item(a.in[16] + (size_t)j * DM * SIN, DM, SIN, (bf16*)(ws + WS_WSIN) + (size_t)j * SINP * DM, a.in[6] + (2 * j + 1) * DM, 0, scr, r, SINP / 64, lane); return; }
    r -= 2 * I_SIN;
    if (r < 2 * I_SOUT) { const int j = r / I_SOUT; r -= j * I_SOUT; tr_item(a.in[23] + (size_t)j * 2048 * DM, 2048, DM, (bf16*)(ws + WS_WSOUT) + (size_t)j * DM * 2048, a.in[22] + j * 2048, 0, scr, r, DM / 64, lane); return; }
    r -= 2 * I_SOUT;
    if (r < 8 * I_GU) { const int q = r / I_GU; r -= q * I_GU; const int i = q >> 1, up = q & 1;
        tr_item(a.in[up ? 25 : 24] + (size_t)i * DM * DFF, DM, DFF, (bf16*)(ws + WS_WGU) + (size_t)i * 2 * DFF * DM, a.in[8] + i * DM, up ? 2 : 1, scr, r, DFF / 64, lane); return; }
    r -= 8 * I_GU;
    { const int i = r / I_DN; r -= i * I_DN; tr_item(a.in[26] + (size_t)i * DFF * DM, DFF, DM, (bf16*)(ws + WS_WDN) + (size_t)i * DM * DFF, nullptr, 0, scr, r, DM / 64, lane); }
}
constexpr int CV_NR = 16;
constexpr int CV_ST[CV_NR] = {O_GIN, O_GOUT, O_GU, O_DN,   O_SIN, O_SOUT, O_GU + 2 * I_GU, O_DN + I_DN,   O_GIN + I_GIN, O_GOUT + I_GOUT, O_GU + 4 * I_GU, O_DN + 2 * I_DN,   O_SIN + I_SIN, O_SOUT + I_SOUT, O_GU + 6 * I_GU, O_DN + 3 * I_DN};
constexpr int CV_LN[CV_NR] = {I_GIN, I_GOUT, 2 * I_GU, I_DN,   I_SIN, I_SOUT, 2 * I_GU, I_DN,   I_GIN, I_GOUT, 2 * I_GU, I_DN,   I_SIN, I_SOUT, 2 * I_GU, I_DN};
constexpr int CV_N0 = I_GIN + I_GOUT + 2 * I_GU + I_DN;
constexpr int CV_TOTAL = 2 * (I_GIN + I_GOUT + I_SIN + I_SOUT) + 4 * (2 * I_GU + I_DN);
__host__ __device__ constexpr int CV_WB(int w) { return w <= 0 ? 0 : w == 1 ? 2200 : w == 2 ? 3350 : w == 3 ? 5450 : w == 4 ? 6600 : w == 5 ? 8800 : w == 6 ? 9950 : (CV_TOTAL - CV_N0); }
static_assert(CV_TOTAL - CV_N0 == 11392, "conversion item count");
__device__ __forceinline__ void phase_convert(const Args& a, LAS unsigned char* lds, int lo, int hi, int worker, int nworkers, int wave, int lane) {
    LAS float* scr = (LAS float*)(lds + wave * 16640);
    for (int v = lo + worker; v < hi; v += nworkers) {
        int r = v, it = 0; bool done = false;
#pragma unroll
        for (int rr = 0; rr < CV_NR; ++rr) { if (!done) { if (r < CV_LN[rr]) { it = CV_ST[rr] + r; done = true; } else r -= CV_LN[rr]; } }
        cvt_item(a, scr, it, lane);
    }
}
__device__ __forceinline__ void phase_prologue(const Args& a, LAS unsigned char* lds, int wave, int lane, int bid, int G) {
    const int gw = bid * 8 + wave, NGW = G * 8;
    unsigned char* ws = a.ws;
    bf16* hn = (bf16*)(ws + WS_HN);
    for (int m = gw; m < T; m += NGW) {
        const float* xrow = m < TP ? a.in[0] + (size_t)m * DM : a.in[1] + (size_t)(m - TP) * DM;
        f32x4 v[4]; float s = 0.f;
#pragma unroll
        for (int jx = 0; jx < 4; ++jx) { v[jx] = *(const f32x4*)(xrow + 4 * lane + 256 * jx); s += (v[jx].x * v[jx].x + v[jx].y * v[jx].y) + (v[jx].z * v[jx].z + v[jx].w * v[jx].w); }
        const float rstd = rsqrtf(wave_sum(lane, s) * (1.f / DM) + EPS);
#pragma unroll
        for (int jx = 0; jx < 4; ++jx) { v2u o; o.x = pk2(v[jx].x * rstd, v[jx].y * rstd); o.y = pk2(v[jx].z * rstd, v[jx].w * rstd); *(v2u*)(hn + (size_t)m * DM + 4 * lane + 256 * jx) = o; }
    }
}

__device__ __forceinline__ void phase_res(const Args& a, int L, bool ffn, int m_lo, int m_hi, int gw, int NGW, int lane, const bf16* gout2, int np2) {
    const bf16* gout = (const bf16*)(a.ws + WS_GOUT);
    const float* postw = (ffn ? a.in[9] : a.in[7]) + L * DM;
    const bool ssd_mix = !ffn && (L & 1);
    const bool first = !ffn && L == 0;
    const float* ssq = (const float*)(a.ws + WS_SSQ);
    bf16* hn = (bf16*)(a.ws + WS_HN);
    f32x4 pw[4];
#pragma unroll
    for (int jx = 0; jx < 4; ++jx) pw[jx] = *(const f32x4*)(postw + 4 * lane + 256 * jx);
    float* sc = (float*)(a.ws + WS_GLAST + 262144);
    const bool last = ffn && L == 3;
    v2u og[4], og2[4], hr[4]; f32x4 xf[4]; float xs_n = 1.f, p_n = 0.f;
#define RES_LOAD(mm) do { const int m_ = (mm);         _Pragma("unroll") for (int jx = 0; jx < 4; ++jx) { og[jx] = *(const v2u*)(gout + (size_t)m_ * DM + 4 * lane + 256 * jx);             if (gout2) og2[jx] = *(const v2u*)(gout2 + (size_t)m_ * DM + 4 * lane + 256 * jx);             if (first) xf[jx] = *(const f32x4*)((m_ < TP ? a.in[0] + (size_t)m_ * DM : a.in[1] + (size_t)(m_ - TP) * DM) + 4 * lane + 256 * jx);             else hr[jx] = *(const v2u*)(hn + (size_t)m_ * DM + 4 * lane + 256 * jx); }         if (!first) xs_n = sc[m_];         if (ssd_mix) p_n = lane < 32 ? ssq[(size_t)m_ * 32 + lane] : 0.f; } while (0)
    int m = m_lo + gw;
    if (m < m_hi) RES_LOAD(m);
    for (; m < m_hi; m += NGW) {
        f32x4 o[4], x[4]; float ss = 0.f; const float xs = first ? 1.f : xs_n; float p = p_n;
#pragma unroll
        for (int jx = 0; jx < 4; ++jx) { o[jx] = (f32x4){bflo(og[jx].x), bfhi(og[jx].x), bflo(og[jx].y), bfhi(og[jx].y)};
            if (gout2) { o[jx] = o[jx] + (f32x4){bflo(og2[jx].x), bfhi(og2[jx].x), bflo(og2[jx].y), bfhi(og2[jx].y)};
                for (int e = 1; e < np2; ++e) { const v2u g3 = *(const v2u*)(gout2 + (size_t)e * (T - TP) * DM + (size_t)m * DM + 4 * lane + 256 * jx); o[jx] = o[jx] + (f32x4){bflo(g3.x), bfhi(g3.x), bflo(g3.y), bfhi(g3.y)}; } }
            if (first) x[jx] = xf[jx]; else x[jx] = (f32x4){bflo(hr[jx].x), bfhi(hr[jx].x), bflo(hr[jx].y), bfhi(hr[jx].y)};
            ss += (o[jx].x * o[jx].x + o[jx].y * o[jx].y) + (o[jx].z * o[jx].z + o[jx].w * o[jx].w); }
        RES_LOAD(m + NGW < m_hi ? m + NGW : m);
        float eps_eff = EPS;
        if (ssd_mix) { p = wave_sum(lane, p); eps_eff = EPS * (p * (1.f / 2048.f) + EPS); }
        const float r1 = rsqrtf(wave_sum(lane, ss) * (1.f / DM) + eps_eff);
        float s2 = 0.f;
#pragma unroll
        for (int jx = 0; jx < 4; ++jx) { x[jx] = x[jx] * xs + o[jx] * r1 * pw[jx]; s2 += (x[jx].x * x[jx].x + x[jx].y * x[jx].y) + (x[jx].z * x[jx].z + x[jx].w * x[jx].w);
            if (last) *(f32x4*)(a.out + (size_t)m * DM + 4 * lane + 256 * jx) = x[jx]; }
        const float s2m = wave_sum(lane, s2) * (1.f / DM) + EPS; const float r2 = rsqrtf(s2m);
        if (!last) {
#pragma unroll
            for (int jx = 0; jx < 4; ++jx) { v2u w; w.x = pk2(x[jx].x * r2, x[jx].y * r2); w.y = pk2(x[jx].z * r2, x[jx].w * r2); *(v2u*)(hn + (size_t)m * DM + 4 * lane + 256 * jx) = w; }
            if (lane == 0) sc[m] = s2m * r2;
        }
    }
#undef RES_LOAD
}

template <bool GDN>
__device__ __forceinline__ void phase_conv(const Args& a, int j, int wave, int lane, int bid, int G) {
    const int gw = bid * 8 + wave, NGW = G * 8;
    const bf16* proj = (const bf16*)(a.ws + WS_PROJ); const int ldc = GDN ? GINP : SINP; const int pc0 = GDN ? 0 : 2048;
    bf16* qkv = (bf16*)(a.ws + WS_QKV);
    const float* cw = (GDN ? a.in[11] : a.in[17]) + (size_t)j * 4 * CONVD;
    const float* cb = a.in[18] + (size_t)j * CONVD;
    const float* cst = (GDN ? a.in[3] : a.in[5]) + (size_t)j * NSEQ_S * 3 * CONVD;
    float* ocp = a.out + (GDN ? O_GCP : O_SCP) + (size_t)j * NSEQ_P * 3 * CONVD;
    float* ocs = a.out + (GDN ? O_GCS : O_SCS) + (size_t)j * NSEQ_S * 3 * CONVD;
    constexpr int NPI = (TP / 16) * 6, NSI = NSEQ_S * 6;
    for (int it = gw; it < NPI + NSI; it += NGW) {
        const bool samp = it >= NPI; const int r = samp ? it - NPI : it; const int sec = r % 6, rb = r / 6;
        const int c = sec * 512 + 8 * lane;
        float w[4][8], bias[8], xa[8], xb[8], xc[8];
#pragma unroll
        for (int jj = 0; jj < 4; ++jj) { const f32x4 wl = *(const f32x4*)(cw + jj * CONVD + c), wh = *(const f32x4*)(cw + jj * CONVD + c + 4);
            w[jj][0] = wl.x; w[jj][1] = wl.y; w[jj][2] = wl.z; w[jj][3] = wl.w; w[jj][4] = wh.x; w[jj][5] = wh.y; w[jj][6] = wh.z; w[jj][7] = wh.w; }
#pragma unroll
        for (int e = 0; e < 8; ++e) bias[e] = GDN ? 0.f : cb[c + e];
        int m0, nrows, bq = 0, t0 = 0;
#define CV_UNPACK(dst, q) do { dst[0] = bflo(q.x); dst[1] = bfhi(q.x); dst[2] = bflo(q.y); dst[3] = bfhi(q.y); dst[4] = bflo(q.z); dst[5] = bfhi(q.z); dst[6] = bflo(q.w); dst[7] = bfhi(q.w); } while (0)
        if (!samp) { bq = rb >> 7; t0 = (rb & 127) * 16; m0 = bq * SEQ + t0; nrows = 16;
            if (t0 != 0) { const v4u ra = *(const v4u*)(proj + (size_t)(m0 - 3) * ldc + pc0 + c), rbb = *(const v4u*)(proj + (size_t)(m0 - 2) * ldc + pc0 + c), rc = *(const v4u*)(proj + (size_t)(m0 - 1) * ldc + pc0 + c);
                CV_UNPACK(xa, ra); CV_UNPACK(xb, rbb); CV_UNPACK(xc, rc); }
            else {
#pragma unroll
                for (int e = 0; e < 8; ++e) { xa[e] = 0.f; xb[e] = 0.f; xc[e] = 0.f; } }
        } else { m0 = TP + 4 * rb; nrows = 4;
#pragma unroll
            for (int hh = 0; hh < 2; ++hh) { const f32x4 va = *(const f32x4*)(cst + ((size_t)rb * 3 + 0) * CONVD + c + 4 * hh), vb = *(const f32x4*)(cst + ((size_t)rb * 3 + 1) * CONVD + c + 4 * hh), vc = *(const f32x4*)(cst + ((size_t)rb * 3 + 2) * CONVD + c + 4 * hh);
                xa[4 * hh] = va.x; xa[4 * hh + 1] = va.y; xa[4 * hh + 2] = va.z; xa[4 * hh + 3] = va.w; xb[4 * hh] = vb.x; xb[4 * hh + 1] = vb.y; xb[4 * hh + 2] = vb.z; xb[4 * hh + 3] = vb.w;
                xc[4 * hh] = vc.x; xc[4 * hh + 1] = vc.y; xc[4 * hh + 2] = vc.z; xc[4 * hh + 3] = vc.w; } }
        v4u rawv[16];
#pragma unroll
        for (int i = 0; i < 16; ++i) { const int ii = i < nrows ? i : nrows - 1; rawv[i] = *(const v4u*)(proj + (size_t)(m0 + ii) * ldc + pc0 + c); }
#pragma unroll
        for (int i = 0; i < 16; ++i) { if (i < nrows) {
            const v4u raw = rawv[i];
            float x[8], y[8]; CV_UNPACK(x, raw);
            float ss = 0.f;
#pragma unroll
            for (int e = 0; e < 8; ++e) { y[e] = silu_f(xa[e] * w[0][e] + xb[e] * w[1][e] + xc[e] * w[2][e] + x[e] * w[3][e] + bias[e]); ss += y[e] * y[e]; }
            if (GDN && sec < 4) { ss += shx<1>(ss, lane); ss += shx<2>(ss, lane); ss += shx<4>(ss, lane); ss += shx<8>(ss, lane);
                const float sc = rsqrtf(ss + 1e-6f) * (sec < 2 ? 0.08838834764831845f : 1.f);
#pragma unroll
                for (int e = 0; e < 8; ++e) y[e] *= sc; }
            v4u o; o.x = pk2(y[0], y[1]); o.y = pk2(y[2], y[3]); o.z = pk2(y[4], y[5]); o.w = pk2(y[6], y[7]);
            *(v4u*)(qkv + (size_t)(m0 + i) * CONVD + c) = o;
            float* cn = nullptr;
            if (!samp) { if (t0 + 16 == SEQ && i >= 13) cn = ocp + ((size_t)bq * 3 + (i - 13)) * CONVD + c; }
            else if (i >= 1) cn = ocs + ((size_t)rb * 3 + (i - 1)) * CONVD + c;
            if (cn) { *(f32x4*)cn = (f32x4){x[0], x[1], x[2], x[3]}; *(f32x4*)(cn + 4) = (f32x4){x[4], x[5], x[6], x[7]}; }
#pragma unroll
            for (int e = 0; e < 8; ++e) { xa[e] = xb[e]; xb[e] = xc[e]; xc[e] = x[e]; }
        } }
#undef CV_UNPACK
    }
    const int gt = bid * 512 + wave * 64 + lane, NT = G * 512;
    float* gb = (float*)(a.ws + WS_GB);
    if (GDN) {
        const float* Alog = a.in[12] + j * 8; const float* dtb = a.in[13] + j * 8;
        for (int idx = gt; idx < T * 8; idx += NT) { const int m = idx >> 3, h = idx & 7;
            const float bb = bf2f(proj[(size_t)m * ldc + 4096 + h]), aa = bf2f(proj[(size_t)m * ldc + 4104 + h]);
            gb[(size_t)m * 16 + h] = sigmoid_f(bb); gb[(size_t)m * 16 + 8 + h] = -__expf(Alog[h]) * softplus_f(aa + dtb[h]); }
    } else {
        const float* dtb = a.in[19] + j * 32;
        for (int idx = gt; idx < T * 32; idx += NT) { const int m = idx >> 5, h = idx & 31;
            gb[(size_t)m * 32 + h] = softplus_f(bf2f(proj[(size_t)m * ldc + 5120 + h]) + dtb[h]); }
    }
}

__device__ __forceinline__ void phase_gp(const Args& a, int jl, LAS unsigned char* lds, int tid, int wave, int lane, int bid, int G) {
    const bf16* qkv = (const bf16*)(a.ws + WS_QKV); const float* gb = (const float*)(a.ws + WS_GB);
    bf16* ch = (bf16*)(a.ws + WS_CH); float* glast = (float*)(a.ws + WS_GLAST);
    constexpr int MF = 0, GLo = 16384, BLo = 16640, EGo = 16896, QL = 17408, KL = 34816, VL = 52224;
    constexpr int XTo = 69632, ATOo = XTo + 36864, SCRo = ATOo + 8192;
    LAS unsigned short* ATOs = (LAS unsigned short*)(lds + ATOo);
    LAS float* GLf = (LAS float*)(lds + GLo); LAS float* BLf = (LAS float*)(lds + BLo); LAS float* EGf = (LAS float*)(lds + EGo); LAS float* MFf = (LAS float*)(lds + MF);
    const int fr = lane & 15, fq = lane >> 4;
    unsigned* gpflag = (unsigned*)(a.ws + WS_BAR + 16384) + jl * 2048;
    v4u pf[6]; float pbe = 0.f, pg_ = 0.f;
#define GP_PREF(qq) do { const int q_ = (qq); const int uid_ = (q_ & 63) * 32 + (q_ >> 6); const int n_ = uid_ & 31, bh_ = uid_ >> 5, h_ = bh_ & 7, b_ = bh_ >> 3; const int mm = b_ * SEQ + n_ * 64; \
        _Pragma("unroll") for (int r = 0; r < 6; ++r) { const int cidx = tid + 512 * r, sect = cidx >> 10, rem = cidx & 1023, row = rem >> 4, cc = rem & 15; \
            pf[r] = *(const v4u*)(qkv + (size_t)(mm + row) * CONVD + sect * 1024 + h_ * 128 + cc * 8); } \
        pbe = gb[(size_t)(mm + lane) * 16 + h_]; pg_ = gb[(size_t)(mm + lane) * 16 + 8 + h_]; } while (0)
    if (bid - 64 < 2048) GP_PREF(bid - 64);
    for (int q = bid - 64; q < 2048; q += G - 64) {
        const int uid = (q & 63) * 32 + (q >> 6);
        bf16* chu = ch + (size_t)uid * CHU;
#pragma unroll
        for (int r = 0; r < 6; ++r) { const int cidx = tid + 512 * r, sect = cidx >> 10, rem = cidx & 1023, row = rem >> 4, cc = rem & 15;
            *(LAS v4u*)(lds + QL + sect * 17408 + row * 272 + cc * 16) = pf[r]; }
        const float be = pbe, g = pg_;
        GP_PREF(q + G - 64 < 2048 ? q + G - 64 : q);
        if (wave == 0) { const float Gc = wave_incl_scan(g, lane);
            GLf[lane] = Gc; BLf[lane] = be; const float eg = __expf(Gc); EGf[lane] = eg; if (lane == 63) __hip_atomic_store((unsigned*)(glast + uid), __float_as_uint(eg), RLX_AGENT_); }
        BAR_LDS();
        {   const int mat = wave >> 2, tr = wave & 3;
            const LAS unsigned char* Ab = lds + (mat == 0 ? KL : QL);
            bf16x8 af[4];
#pragma unroll
            for (int kk = 0; kk < 4; ++kk) af[kk] = *(const LAS bf16x8*)(Ab + (tr * 16 + fr) * 272 + (kk * 32 + fq * 8) * 2);
#pragma unroll
            for (int tc = 0; tc < 4; ++tc) {
                const int jcol = tc * 16 + fr;
                if (tc <= tr) {
                    f32x4 acc = {0.f, 0.f, 0.f, 0.f};
#pragma unroll
                    for (int kk = 0; kk < 4; ++kk) { const bf16x8 bfr = *(const LAS bf16x8*)(lds + KL + (tc * 16 + fr) * 272 + (kk * 32 + fq * 8) * 2); acc = MFMA16(af[kk], bfr, acc); }
                    const float Gj = GLf[jcol];
#pragma unroll
                    for (int r = 0; r < 4; ++r) { const int i = tr * 16 + fq * 4 + r; const float Gi = GLf[i];
                        const float e = (i >= jcol) ? __expf(Gi - Gj) : 0.f;
                        if (mat == 0) MFf[i * 64 + jcol] = (i > jcol) ? BLf[i] * acc[r] * e : 0.f;
                        else ATOs[i * 64 + jcol] = f2bf(acc[r] * e); }
                } else if (mat == 1) {
#pragma unroll
                    for (int r = 0; r < 4; ++r) { const int i = tr * 16 + fq * 4 + r; ATOs[i * 64 + jcol] = 0; }
                }
            }
        }
        BAR_LDS();
        if (tid < 256) {
            const bool isU = tid < 128; const int cc = tid & 127;
            const LAS unsigned char* src = lds + (isU ? VL : KL);
            LAS unsigned char* xt = lds + XTo + tid * 144;
            LAS unsigned char* scr = lds + SCRo + wave * 5120;
            float rr[16];
#pragma unroll
            for (int ib = 0; ib < 4; ++ib) {
                const int i0 = 16 * ib;
#pragma unroll
                for (int r = 0; r < 16; ++r) { const float egi = EGf[i0 + r]; rr[r] = bf2f(*(const LAS unsigned short*)(src + (i0 + r) * 272 + cc * 2)) * BLf[i0 + r] * (isU ? 1.0f : egi); }
                if (ib > 0) {
                    const bool v0 = 8 * fq < i0;
                    bf16x8 a0 = {0, 0, 0, 0, 0, 0, 0, 0}, a1 = {0, 0, 0, 0, 0, 0, 0, 0};
                    if (v0) { const f32x4 m0 = *(const LAS f32x4*)(lds + MF + ((i0 + fr) * 64 + 8 * fq) * 4), m1 = *(const LAS f32x4*)(lds + MF + ((i0 + fr) * 64 + 8 * fq + 4) * 4);
                        v4u p; p.x = pk2(m0.x, m0.y); p.y = pk2(m0.z, m0.w); p.z = pk2(m1.x, m1.y); p.w = pk2(m1.z, m1.w); a0 = __builtin_bit_cast(bf16x8, p); }
                    if (ib == 3 && fq < 2) { const f32x4 m0 = *(const LAS f32x4*)(lds + MF + ((i0 + fr) * 64 + 32 + 8 * fq) * 4), m1 = *(const LAS f32x4*)(lds + MF + ((i0 + fr) * 64 + 32 + 8 * fq + 4) * 4);
                        v4u p; p.x = pk2(m0.x, m0.y); p.y = pk2(m0.z, m0.w); p.z = pk2(m1.x, m1.y); p.w = pk2(m1.z, m1.w); a1 = __builtin_bit_cast(bf16x8, p); }
#pragma unroll
                    for (int t = 0; t < 4; ++t) {
                        const LAS unsigned char* xc = lds + XTo + (wave * 64 + t * 16 + fr) * 144;
                        bf16x8 b0 = {0, 0, 0, 0, 0, 0, 0, 0};
                        if (v0) b0 = *(const LAS bf16x8*)(xc + 16 * fq);
                        f32x4 acc = {0.f, 0.f, 0.f, 0.f};
                        acc = MFMA16(a0, b0, acc);
                        if (ib == 3) { bf16x8 b1 = {0, 0, 0, 0, 0, 0, 0, 0}; if (fq < 2) b1 = *(const LAS bf16x8*)(xc + 64 + 16 * fq); acc = MFMA16(a1, b1, acc); }
                        *(LAS f32x4*)(scr + (t * 16 + fr) * 80 + 16 * fq) = acc;
                    }
                    LDS_WAIT();
#pragma unroll
                    for (int q4 = 0; q4 < 4; ++q4) { const f32x4 d = *(const LAS f32x4*)(scr + lane * 80 + 16 * q4); rr[4 * q4] -= d.x; rr[4 * q4 + 1] -= d.y; rr[4 * q4 + 2] -= d.z; rr[4 * q4 + 3] -= d.w; }
                    LDS_WAIT();
                }
#pragma unroll
                for (int rb = 0; rb < 4; ++rb) {
#pragma unroll
                    for (int r = 4 * rb; r < 4 * rb + 4; ++r) {
#pragma unroll
                        for (int r2 = 0; r2 < r; ++r2) rr[r] -= MFf[(i0 + r) * 64 + i0 + r2] * rr[r2]; }
                    asm volatile("" : "+v"(rr[4 * rb]), "+v"(rr[4 * rb + 1]), "+v"(rr[4 * rb + 2]), "+v"(rr[4 * rb + 3]) :: "memory");
                }
                v4u o0, o1; o0.x = pk2(rr[0], rr[1]); o0.y = pk2(rr[2], rr[3]); o0.z = pk2(rr[4], rr[5]); o0.w = pk2(rr[6], rr[7]);
                o1.x = pk2(rr[8], rr[9]); o1.y = pk2(rr[10], rr[11]); o1.z = pk2(rr[12], rr[13]); o1.w = pk2(rr[14], rr[15]);
                *(LAS v4u*)(xt + 32 * ib) = o0; *(LAS v4u*)(xt + 32 * ib + 16) = o1;
                LDS_WAIT();
            }
        } else {
            const int tt = tid - 256;
#pragma unroll
            for (int r = 0; r < 4; ++r) { const int chunk = tt + 256 * r, row = chunk >> 4, cch = chunk & 15;
                const v4u qv = *(const LAS v4u*)(lds + QL + row * 272 + cch * 16); const float e = EGf[row];
                v4u o; o.x = pk2(bflo(qv.x) * e, bfhi(qv.x) * e); o.y = pk2(bflo(qv.y) * e, bfhi(qv.y) * e); o.z = pk2(bflo(qv.z) * e, bfhi(qv.z) * e); o.w = pk2(bflo(qv.w) * e, bfhi(qv.w) * e);
                st16_wt(chu + OFF_QG + row * 128 + cch * 8, o); }
            const float Gl = GLf[63];
#pragma unroll
            for (int r = 0; r < 4; ++r) { const int chunk = tt + 256 * r, kk = chunk & 127, cg8 = chunk >> 7;
                float v[8];
#pragma unroll
                for (int e = 0; e < 8; ++e) { const int ci = cg8 * 8 + e; v[e] = bf2f(*(const LAS unsigned short*)(lds + KL + ci * 272 + kk * 2)) * __expf(Gl - GLf[ci]); }
                v4u o; o.x = pk2(v[0], v[1]); o.y = pk2(v[2], v[3]); o.z = pk2(v[4], v[5]); o.w = pk2(v[6], v[7]);
                st16_wt(chu + OFF_KDT + kk * 64 + cg8 * 8, o); }
        }
        BAR_LDS();
#pragma unroll
        for (int r = 0; r < 4; ++r) { const int chunk = tid + 512 * r, mcol = (chunk >> 10) * 128 + (chunk & 15) * 8, row = (chunk & 1023) >> 4;
            unsigned short e8[8];
#pragma unroll
            for (int e = 0; e < 8; ++e) e8[e] = *(const LAS unsigned short*)(lds + XTo + (mcol + e) * 144 + row * 2);
            v4u o; o.x = e8[0] | ((unsigned)e8[1] << 16); o.y = e8[2] | ((unsigned)e8[3] << 16); o.z = e8[4] | ((unsigned)e8[5] << 16); o.w = e8[6] | ((unsigned)e8[7] << 16);
            st16_wt(chu + OFF_U + chunk * 8, o); }
        st16_wt(chu + OFF_ATTN + tid * 8, *(const LAS v4u*)(lds + ATOo + tid * 16));
        asm volatile("s_waitcnt vmcnt(0)" ::: "memory");
        __syncthreads();
        if (tid == 0) __hip_atomic_store(gpflag + uid, 1u, RLX_AGENT_);
    }
}

__device__ __forceinline__ void phase_gs(const Args& a, int j, LAS unsigned char* lds, int tid, int wave, int lane, int bid, int G) {
    constexpr int WL = 0, QGL = 17408, UL = 34816, KDTL = 52224, ATL = 70656, SBL = 79872, VNL = 114688;
    const bf16* ch = (const bf16*)(a.ws + WS_CH); const float* glast = (const float*)(a.ws + WS_GLAST);
    const bf16* proj = (const bf16*)(a.ws + WS_PROJ); bf16* obuf = (bf16*)(a.ws + WS_OBUF);
    const float* nw = a.in[14] + j * 128;
    const int fr = lane & 15, fq = lane >> 4, row8 = tid >> 3, seg = tid & 7;
    constexpr int NWL = 133120;
    if (tid < 128) ((LAS float*)(lds + NWL))[tid] = nw[tid];
    for (int rp = 0; rp < REP_PROMPT; ++rp)
    for (int u = bid; u < 64; u += G) {
        const int b = u >> 3, h = u & 7;
        f32x4 St[8];
#pragma unroll
        for (int kt = 0; kt < 8; ++kt) St[kt] = (f32x4){0.f, 0.f, 0.f, 0.f};
        v4u pu[2], pw[2], pq[2], pk[2], pa, zc[2]; float gl_next, gl_cur;
#define GS_LOAD(nn) do { const bf16* cu = ch + (size_t)(u * 32 + (nn)) * CHU; \
            _Pragma("unroll") for (int r = 0; r < 2; ++r) { const int chunk = tid + 512 * r; pu[r] = *(const v4u*)(cu + OFF_U + chunk * 8); pw[r] = *(const v4u*)(cu + OFF_W + chunk * 8); \
                pq[r] = *(const v4u*)(cu + OFF_QG + chunk * 8); pk[r] = *(const v4u*)(cu + OFF_KDT + chunk * 8); } \
            pa = *(const v4u*)(cu + OFF_ATTN + tid * 8); \
            gl_next = glast[u * 32 + (nn)]; } while (0)
#define GS_STORE() do { \
            _Pragma("unroll") for (int r = 0; r < 2; ++r) { const int chunk = tid + 512 * r, row = chunk >> 4, cch = chunk & 15; \
                *(LAS v4u*)(lds + UL + row * 272 + cch * 16) = pu[r]; *(LAS v4u*)(lds + WL + row * 272 + cch * 16) = pw[r]; *(LAS v4u*)(lds + QGL + row * 272 + cch * 16) = pq[r]; \
                const int rowk = chunk >> 3, cck = chunk & 7; *(LAS v4u*)(lds + KDTL + rowk * 144 + cck * 16) = pk[r]; } \
            *(LAS v4u*)(lds + ATL + row8 * 144 + seg * 16) = pa; gl_cur = gl_next; } while (0)
        unsigned* flg = (unsigned*)(a.ws + WS_BAR + 16384) + j * 2048 + u * 32;
        if (wave == 0) { wait_flag_set(flg + 0, 0u); wait_flag_set(flg + 1, 0u); __builtin_amdgcn_fence(__ATOMIC_ACQUIRE, "agent"); asm volatile("s_waitcnt vmcnt(0)" ::: "memory"); }
        BAR_LDS();
        GS_LOAD(0);
        GS_STORE();
        for (int n = 0; n < 32; ++n) {
            unsigned fnext = 1u;
            if (wave == 0 && n + 2 < 32) fnext = __hip_atomic_load(flg + n + 2, RLX_AGENT_);
            { const bf16* zp = proj + (size_t)(b * SEQ + n * 64 + row8) * GINP + 3072 + h * 128 + seg * 16; zc[0] = *(const v4u*)zp; zc[1] = *(const v4u*)(zp + 8); }
            GS_LOAD(n + 1 < 32 ? n + 1 : 31);
#pragma unroll
            for (int kt = 0; kt < 8; ++kt) { v2u w2; w2.x = pk2(St[kt][0], St[kt][1]); w2.y = pk2(St[kt][2], St[kt][3]);
                *(LAS v2u*)(lds + SBL + (16 * wave + fr) * 272 + (kt * 16 + fq * 4) * 2) = w2; }
            BAR_LDS();
            bf16x8 bS[4];
#pragma unroll
            for (int kk = 0; kk < 4; ++kk) bS[kk] = *(const LAS bf16x8*)(lds + SBL + (16 * wave + fr) * 272 + (kk * 32 + fq * 8) * 2);
            f32x4 accQ[4];
#pragma unroll
            for (int ct = 0; ct < 4; ++ct) {
                f32x4 aw = {0.f, 0.f, 0.f, 0.f}, aq = {0.f, 0.f, 0.f, 0.f};
#pragma unroll
                for (int kk = 0; kk < 4; ++kk) { const bf16x8 fa = *(const LAS bf16x8*)(lds + WL + (ct * 16 + fr) * 272 + (kk * 32 + fq * 8) * 2); aw = MFMA16(fa, bS[kk], aw);
                    const bf16x8 fb = *(const LAS bf16x8*)(lds + QGL + (ct * 16 + fr) * 272 + (kk * 32 + fq * 8) * 2); aq = MFMA16(fb, bS[kk], aq); }
                float vn[4];
#pragma unroll
                for (int r = 0; r < 4; ++r) vn[r] = bf2f(*(const LAS unsigned short*)(lds + UL + (ct * 16 + fq * 4 + r) * 272 + (16 * wave + fr) * 2)) - aw[r];
                v2u w2; w2.x = pk2(vn[0], vn[1]); w2.y = pk2(vn[2], vn[3]);
                *(LAS v2u*)(lds + VNL + (16 * wave + fr) * 144 + (ct * 16 + fq * 4) * 2) = w2;
                accQ[ct] = aq;
            }
            LDS_WAIT();
            bf16x8 bV[2];
#pragma unroll
            for (int jj = 0; jj < 2; ++jj) bV[jj] = *(const LAS bf16x8*)(lds + VNL + (16 * wave + fr) * 144 + (jj * 32 + fq * 8) * 2);
#pragma unroll
            for (int ct = 0; ct < 4; ++ct)
#pragma unroll
                for (int jj = 0; jj < 2; ++jj) { const bf16x8 fa = *(const LAS bf16x8*)(lds + ATL + (ct * 16 + fr) * 144 + (jj * 32 + fq * 8) * 2); accQ[ct] = MFMA16(fa, bV[jj], accQ[ct]); }
#pragma unroll
            for (int kt = 0; kt < 8; ++kt) { St[kt] = St[kt] * gl_cur;
#pragma unroll
                for (int jj = 0; jj < 2; ++jj) { const bf16x8 fa = *(const LAS bf16x8*)(lds + KDTL + (kt * 16 + fr) * 144 + (jj * 32 + fq * 8) * 2); St[kt] = MFMA16(fa, bV[jj], St[kt]); } }
#pragma unroll
            for (int ct = 0; ct < 4; ++ct) { v2u w2; w2.x = pk2(accQ[ct][0], accQ[ct][1]); w2.y = pk2(accQ[ct][2], accQ[ct][3]);
                *(LAS v2u*)(lds + VNL + (16 * wave + fr) * 144 + (ct * 16 + fq * 4) * 2) = w2; }
            if (wave == 0 && n + 2 < 32) { wait_flag_set(flg + n + 2, fnext); __builtin_amdgcn_fence(__ATOMIC_ACQUIRE, "agent"); asm volatile("s_waitcnt vmcnt(0)" ::: "memory"); }
            BAR_LDS();
            GS_STORE();
            {   float ov[16]; float ss = 0.f;
#pragma unroll
                for (int e = 0; e < 16; ++e) { ov[e] = bf2f(*(const LAS unsigned short*)(lds + VNL + (seg * 16 + e) * 144 + row8 * 2)); ss += ov[e] * ov[e]; }
                ss += shx<1>(ss, lane); ss += shx<2>(ss, lane); ss += shx<4>(ss, lane);
                const float rstd = rsqrtf(ss * (1.f / 128.f) + EPS);
                v4u o2[2];
#pragma unroll
                for (int q = 0; q < 4; ++q) { const f32x4 wv = *(const LAS f32x4*)(lds + NWL + (seg * 16 + q * 4) * 4);
                    const unsigned z0 = zc[q >> 1][(q & 1) * 2], z1 = zc[q >> 1][(q & 1) * 2 + 1];
                    const float r0 = ov[4 * q] * rstd * wv.x * silu_f(bflo(z0)), r1 = ov[4 * q + 1] * rstd * wv.y * silu_f(bfhi(z0));
                    const float r2 = ov[4 * q + 2] * rstd * wv.z * silu_f(bflo(z1)), r3 = ov[4 * q + 3] * rstd * wv.w * silu_f(bfhi(z1));
                    o2[q >> 1][(q & 1) * 2] = pk2(r0, r1); o2[q >> 1][(q & 1) * 2 + 1] = pk2(r2, r3); }
                bf16* op = obuf + (size_t)(b * SEQ + n * 64 + row8) * 1024 + h * 128 + seg * 16;
                *(v4u*)op = o2[0]; *(v4u*)(op + 8) = o2[1];
            }
        }
        float* so = a.out + O_GSP + ((size_t)(j * 8 + b) * 8 + h) * 16384;
#pragma unroll
        for (int kt = 0; kt < 8; ++kt)
#pragma unroll
            for (int r = 0; r < 4; ++r) so[(kt * 16 + fq * 4 + r) * 128 + 16 * wave + fr] = St[kt][r];
        BAR_LDS();
    }
#undef GS_LOAD
#undef GS_STORE
    {
        int first, stride;
        if (G > 64) { first = bid - 64; stride = G - 64; } else { first = bid; stride = G; }
        const float* S0 = a.in[2] + (size_t)j * NSEQ_S * 8 * 16384;
        const bf16* qkv = (const bf16*)(a.ws + WS_QKV); const float* gb = (const float*)(a.ws + WS_GB);
        LAS float* qS = (LAS float*)lds;
        LAS float* kS = qS + 512; LAS float* vS = qS + 1024;
        LAS float* part = qS + 1536;
        LAS float* oS = part + 2048;
        LAS float* qkS = oS + 512;
        const int vq = tid & 31, kg = tid >> 5;
        if (first >= 0)
        for (int u = first; u < NSEQ_S * 8; u += stride) {
            const int b = u >> 3, h = u & 7; const int m0 = TP + 4 * b;
            f32x4 Sr[8];
            const float* sp = S0 + (size_t)u * 16384;
#pragma unroll
            for (int i = 0; i < 8; ++i) Sr[i] = *(const f32x4*)(sp + (kg * 8 + i) * 128 + vq * 4);
            for (int e = tid; e < 1536; e += 512) { const int tok = e / 384, rem = e - tok * 384, sect = rem >> 7, c = rem & 127;
                qS[sect * 512 + tok * 128 + c] = bf2f(qkv[(size_t)(m0 + tok) * CONVD + sect * 1024 + h * 128 + c]); }
            BAR_LDS();
            if (wave < 4) { const float d = qS[wave * 128 + lane] * kS[wave * 128 + lane] + qS[wave * 128 + 64 + lane] * kS[wave * 128 + 64 + lane]; const float s = wave_sum(lane, d); if (lane == 0) qkS[wave] = s; }
            BAR_LDS();
            for (int tok = 0; tok < 4; ++tok) {
                f32x4 pk4 = {0.f, 0.f, 0.f, 0.f}, pq4 = {0.f, 0.f, 0.f, 0.f};
#pragma unroll
                for (int i = 0; i < 8; ++i) { const float kv = kS[tok * 128 + kg * 8 + i], qv = qS[tok * 128 + kg * 8 + i]; pk4 += kv * Sr[i]; pq4 += qv * Sr[i]; }
#pragma unroll
                for (int e = 0; e < 4; ++e) { pk4[e] += shx<32>(pk4[e], lane); pq4[e] += shx<32>(pq4[e], lane); }
                if (lane < 32) { *(LAS f32x4*)(part + wave * 256 + vq * 4) = pk4; *(LAS f32x4*)(part + wave * 256 + 128 + vq * 4) = pq4; }
                BAR_LDS();
                f32x4 kSv = {0.f, 0.f, 0.f, 0.f}, qSv = {0.f, 0.f, 0.f, 0.f};
#pragma unroll
                for (int w = 0; w < 8; ++w) { kSv += *(const LAS f32x4*)(part + w * 256 + vq * 4); qSv += *(const LAS f32x4*)(part + w * 256 + 128 + vq * 4); }
                const float bt = gb[(size_t)(m0 + tok) * 16 + h], eg = __expf(gb[(size_t)(m0 + tok) * 16 + 8 + h]);
                const f32x4 vv = *(const LAS f32x4*)(vS + tok * 128 + vq * 4);
                const f32x4 dv4 = vv - eg * kSv;
                const f32x4 o4 = eg * qSv + (bt * qkS[tok]) * dv4;
#pragma unroll
                for (int i = 0; i < 8; ++i) { const float kv = kS[tok * 128 + kg * 8 + i]; Sr[i] = eg * Sr[i] + (bt * kv) * dv4; }
                if (tid < 32) *(LAS f32x4*)(oS + tok * 128 + vq * 4) = o4;
                BAR_LDS();
            }
            if (tid < 256) { const int tok = wave; const f32x2 o2 = *(const LAS f32x2*)(oS + tok * 128 + 2 * lane);
                const float ss = wave_sum(lane, o2.x * o2.x + o2.y * o2.y); const float rstd = rsqrtf(ss * (1.f / 128.f) + EPS);
                const unsigned zz = *(const unsigned*)(proj + (size_t)(m0 + tok) * GINP + 3072 + h * 128 + 2 * lane);
                const f32x2 wv = *(const f32x2*)(nw + 2 * lane);
                *(unsigned*)(obuf + (size_t)(m0 + tok) * 1024 + h * 128 + 2 * lane) = pk2(o2.x * rstd * wv.x * silu_f(bflo(zz)), o2.y * rstd * wv.y * silu_f(bfhi(zz))); }
            float* so = a.out + O_GSS + ((size_t)j * NSEQ_S * 8 + u) * 16384;
#pragma unroll
            for (int i = 0; i < 8; ++i) *(f32x4*)(so + (kg * 8 + i) * 128 + vq * 4) = Sr[i];
            BAR_LDS();
        }
    }
}

__device__ __forceinline__ void phase_ss(const Args& a, int j, LAS unsigned char* lds, int tid, int wave, int lane, int bid, int G) {
    constexpr int CL = 0, BLo = 17408, BTL = 34816, XSL = 53248, XDT = 62464, XWT = 71680, LLo = 80896, HBL = 90112, YL = 107520, ACL = 124928;
    const bf16* xbc = (const bf16*)(a.ws + WS_QKV); const float* dtb = (const float*)(a.ws + WS_GB);
    const bf16* proj = (const bf16*)(a.ws + WS_PROJ); bf16* obuf = (bf16*)(a.ws + WS_OBUF); float* ssq = (float*)(a.ws + WS_SSQ);
    const float* Alog = a.in[20] + j * 32; const float* Dsk = a.in[21] + j * 32;
    const int fr = lane & 15, fq = lane >> 4, row8 = tid >> 3, seg = tid & 7;
    LAS float* ACf = (LAS float*)(lds + ACL); LAS float* YLf = (LAS float*)(lds + YL);
    const int ptile = wave & 3, sg = wave >> 2;
    const float* H0 = a.in[4] + (size_t)j * NSEQ_S * 32 * 8192;
    LAS float* xsS = (LAS float*)(lds + 125440);
    LAS float* BS = xsS + 256;
    LAS float* CS = BS + 512;
    LAS float* yS = CS + 512;
    const int sq = tid & 7, pg = tid >> 3;
    f32x4 Hn[4]; unsigned short sgv[3]; float sdt[4]; unsigned short sz;
#define SSS_PREF(uu) do { const int u_ = (uu); const int b_ = u_ >> 5, h_ = u_ & 31, g_ = h_ >> 3; const int mm = TP + 4 * b_; \
        const float* hp = H0 + (size_t)u_ * 8192; \
        _Pragma("unroll") for (int i = 0; i < 4; ++i) Hn[i] = *(const f32x4*)(hp + pg * 128 + 16 * sq + 4 * i); \
        _Pragma("unroll") for (int k = 0; k < 3; ++k) { { const int e0 = tid + 512 * k; const int e = e0 < 1280 ? e0 : 1279; const int tok = e / 320, rem = e - tok * 320; \
            const int col = rem < 64 ? h_ * 64 + rem : (rem < 192 ? 2048 + g_ * 128 + rem - 64 : 2560 + g_ * 128 + rem - 192); sgv[k] = xbc[(size_t)(mm + tok) * CONVD + col]; } } \
        _Pragma("unroll") for (int k = 0; k < 4; ++k) sdt[k] = dtb[(size_t)(mm + k) * 32 + h_]; \
        sz = proj[(size_t)(mm + (tid >> 6 & 3)) * SINP + h_ * 64 + (tid & 63)]; } while (0)
    const bool inter = (G == 256);
    int su = bid;
    if (su < NSEQ_S * 32) SSS_PREF(su);
    for (int rp = 0; rp < REP_PROMPT; ++rp)
    for (int u0 = bid; u0 < 256; u0 += G) {
        int u = u0;
        if (G == 256) { const int x = u0 & 7, sl = u0 >> 3, pgi = x + 8 * (sl >> 3); u = (pgi >> 2) * 32 + (pgi & 3) * 8 + (sl & 7); }
        const int b = u >> 5, h = u & 31, g = h >> 3; const float Ah = -__expf(Alog[h]); const float Dh = Dsk[h];
        f32x4 Hs[4];
#pragma unroll
        for (int q = 0; q < 4; ++q) Hs[q] = (f32x4){0.f, 0.f, 0.f, 0.f};
        v4u px, pB[2], pC[2], zc; float pdt;
#define SS_LOAD(nn) do { const int m0_ = b * SEQ + (nn) * 64; \
            px = *(const v4u*)(xbc + (size_t)(m0_ + row8) * CONVD + h * 64 + seg * 8); \
            _Pragma("unroll") for (int r = 0; r < 2; ++r) { const int chunk = tid + 512 * r, row = chunk >> 4, cch = chunk & 15; \
                pB[r] = *(const v4u*)(xbc + (size_t)(m0_ + row) * CONVD + 2048 + g * 128 + cch * 8); pC[r] = *(const v4u*)(xbc + (size_t)(m0_ + row) * CONVD + 2560 + g * 128 + cch * 8); } \
            pdt = dtb[(size_t)(m0_ + lane) * 32 + h]; } while (0)
#define SS_FILL() do { const float Ac = wave_incl_scan(pdt * Ah, lane); const float Ac_r = shi(Ac, row8), dt_r = shi(pdt, row8), last_ = __int_as_float(__builtin_amdgcn_readlane(__float_as_int(Ac), 63)); \
            if (wave == 0) ACf[lane] = Ac; \
            _Pragma("unroll") for (int r = 0; r < 2; ++r) { const int chunk = tid + 512 * r, row = chunk >> 4, cch = chunk & 15; \
                *(LAS v4u*)(lds + BLo + row * 272 + cch * 16) = pB[r]; *(LAS v4u*)(lds + CL + row * 272 + cch * 16) = pC[r]; \
                _Pragma("unroll") for (int e = 0; e < 4; ++e) { const unsigned wv = pB[r][e]; \
                    *(LAS unsigned short*)(lds + BTL + tsw_w(cch * 8 + 2 * e, row)) = (unsigned short)(wv & 0xffffu); \
                    *(LAS unsigned short*)(lds + BTL + tsw_w(cch * 8 + 2 * e + 1, row)) = (unsigned short)(wv >> 16); } } \
            *(LAS v4u*)(lds + XSL + row8 * 144 + seg * 16) = px; \
            const float wt_ = dt_r * __expf(last_ - Ac_r); \
            _Pragma("unroll") for (int e = 0; e < 4; ++e) { const float x0 = bflo(px[e]), x1 = bfhi(px[e]); \
                *(LAS unsigned short*)(lds + XDT + tsw_w(seg * 8 + 2 * e, row8)) = f2bf(x0 * dt_r); *(LAS unsigned short*)(lds + XDT + tsw_w(seg * 8 + 2 * e + 1, row8)) = f2bf(x1 * dt_r); \
                *(LAS unsigned short*)(lds + XWT + tsw_w(seg * 8 + 2 * e, row8)) = f2bf(x0 * wt_); *(LAS unsigned short*)(lds + XWT + tsw_w(seg * 8 + 2 * e + 1, row8)) = f2bf(x1 * wt_); } \
            } while (0)
        SS_LOAD(0);
        SS_FILL();
        for (int n = 0; n < 32; ++n) {
            const int m0 = b * SEQ + n * 64;
            zc = *(const v4u*)(proj + (size_t)(m0 + row8) * SINP + h * 64 + seg * 8);
            SS_LOAD(n + 1 < 32 ? n + 1 : 31);
            const bool sstep = inter && ((n & 1) == 0) && su < NSEQ_S * 32;
            const int sb_ = su >> 5, sh_ = su & 31; const int sm0 = TP + 4 * sb_;
            if (sstep) {
#pragma unroll
                for (int k = 0; k < 3; ++k) { const int e = tid + 512 * k; if (e < 1280) { const int tok = e / 320, rem = e - tok * 320; const float v = bf2f(sgv[k]);
                    if (rem < 64) xsS[tok * 64 + rem] = v; else if (rem < 192) BS[tok * 128 + rem - 64] = v; else CS[tok * 128 + rem - 192] = v; } }
            }
#pragma unroll
            for (int q = 0; q < 4; ++q) { const int stile = 4 * sg + q; v2u w2; w2.x = pk2(Hs[q][0], Hs[q][1]); w2.y = pk2(Hs[q][2], Hs[q][3]);
                *(LAS v2u*)(lds + HBL + (16 * ptile + fr) * 272 + (stile * 16 + fq * 4) * 2) = w2; }
            BAR_LDS();
            if (sstep) {
                const float sAh = -__expf(Alog[sh_]);
#pragma unroll
                for (int tok = 0; tok < 4; ++tok) {
                    const float dt = sdt[tok]; const float dA = __expf(dt * sAh);
                    const float dx = dt * xsS[tok * 64 + pg]; float y = 0.f;
#pragma unroll
                    for (int i = 0; i < 4; ++i) { const f32x4 B4 = *(const LAS f32x4*)(BS + tok * 128 + 16 * sq + 4 * i), C4 = *(const LAS f32x4*)(CS + tok * 128 + 16 * sq + 4 * i);
                        Hn[i] = dA * Hn[i] + dx * B4; y += (Hn[i].x * C4.x + Hn[i].y * C4.y) + (Hn[i].z * C4.z + Hn[i].w * C4.w); }
                    y += shx<1>(y, lane); y += shx<2>(y, lane); y += shx<4>(y, lane);
                    if (sq == 0) yS[tok * 64 + pg] = y;
                }
            }
#pragma unroll
            for (int tt = 0; tt < 2; ++tt) { const int id = 2 * wave + tt, tr = id >> 2, tc = id & 3; const int jcol = tc * 16 + fr;
                if (tc <= tr) {
                    f32x4 acc = {0.f, 0.f, 0.f, 0.f};
#pragma unroll
                    for (int kk = 0; kk < 4; ++kk) { const bf16x8 fa = *(const LAS bf16x8*)(lds + CL + (tr * 16 + fr) * 272 + (kk * 32 + fq * 8) * 2);
                        const bf16x8 fb = *(const LAS bf16x8*)(lds + BLo + (tc * 16 + fr) * 272 + (kk * 32 + fq * 8) * 2); acc = MFMA16(fa, fb, acc); }
                    const float Aj = ACf[jcol];
#pragma unroll
                    for (int r = 0; r < 4; ++r) { const int i = tr * 16 + fq * 4 + r; const float val = (i >= jcol) ? acc[r] * __expf(ACf[i] - Aj) : 0.f;
                        *(LAS unsigned short*)(lds + LLo + i * 144 + jcol * 2) = f2bf(val); }
                } else {
#pragma unroll
                    for (int r = 0; r < 4; ++r) { const int i = tr * 16 + fq * 4 + r; *(LAS unsigned short*)(lds + LLo + i * 144 + jcol * 2) = 0; }
                }
            }
            BAR_LDS();
            if (sstep) {
                if (tid < 256) { const int tok = wave, p = lane;
                    const float val = (yS[tok * 64 + p] + Dsk[sh_] * xsS[tok * 64 + p]) * silu_f(bf2f(sz));
                    const float ss = wave_sum(lane, val * val); if (lane == 0) ssq[(size_t)(sm0 + tok) * 32 + sh_] = ss;
                    obuf[(size_t)(sm0 + tok) * 2048 + sh_ * 64 + p] = f2bf(val); }
                float* sho = a.out + O_SHS + ((size_t)j * NSEQ_S * 32 + su) * 8192;
#pragma unroll
                for (int i = 0; i < 4; ++i) *(f32x4*)(sho + pg * 128 + 16 * sq + 4 * i) = Hn[i];
                su += G;
                SSS_PREF(su < NSEQ_S * 32 ? su : su - G);
            }
            const float last = ACf[63];
#pragma unroll
            for (int tt = 0; tt < 2; ++tt) { const int it = 2 * sg + tt;
                f32x4 acc = {0.f, 0.f, 0.f, 0.f};
#pragma unroll
                for (int kk = 0; kk < 4; ++kk) { const bf16x8 fa = *(const LAS bf16x8*)(lds + CL + (it * 16 + fr) * 272 + (kk * 32 + fq * 8) * 2);
                    const bf16x8 fb = *(const LAS bf16x8*)(lds + HBL + (16 * ptile + fr) * 272 + (kk * 32 + fq * 8) * 2); acc = MFMA16(fa, fb, acc); }
#pragma unroll
                for (int r = 0; r < 4; ++r) acc[r] *= __expf(ACf[it * 16 + fq * 4 + r]);
#pragma unroll
                for (int jj = 0; jj < 2; ++jj) { const bf16x8 fa = *(const LAS bf16x8*)(lds + LLo + (it * 16 + fr) * 144 + (jj * 32 + fq * 8) * 2);
                    const bf16x8 fb = *(const LAS bf16x8*)(lds + XDT + tsw_r(16 * ptile + fr, jj * 4 + fq)); acc = MFMA16(fa, fb, acc); }
#pragma unroll
                for (int r = 0; r < 4; ++r) YLf[(it * 16 + fq * 4 + r) * 68 + 16 * ptile + fr] = acc[r];
            }
            {   const float eL = __expf(last);
                bf16x8 bX[2];
#pragma unroll
                for (int jj = 0; jj < 2; ++jj) bX[jj] = *(const LAS bf16x8*)(lds + XWT + tsw_r(16 * ptile + fr, jj * 4 + fq));
#pragma unroll
                for (int q = 0; q < 4; ++q) { const int stile = 4 * sg + q; Hs[q] = Hs[q] * eL;
#pragma unroll
                    for (int jj = 0; jj < 2; ++jj) { const bf16x8 fa = *(const LAS bf16x8*)(lds + BTL + tsw_r(stile * 16 + fr, jj * 4 + fq)); Hs[q] = MFMA16(fa, bX[jj], Hs[q]); } }
            }
            BAR_LDS();
            {   const f32x4 y0 = *(const LAS f32x4*)(lds + YL + (row8 * 68 + seg * 8) * 4), y1 = *(const LAS f32x4*)(lds + YL + (row8 * 68 + seg * 8 + 4) * 4);
                const v4u xv = *(const LAS v4u*)(lds + XSL + row8 * 144 + seg * 16);
                float val[8]; float ss = 0.f;
#pragma unroll
                for (int e = 0; e < 4; ++e) { const float ya = e < 2 ? y0[2 * e] : y1[2 * e - 4], yb = e < 2 ? y0[2 * e + 1] : y1[2 * e - 3];
                    val[2 * e] = (ya + Dh * bflo(xv[e])) * silu_f(bflo(zc[e])); val[2 * e + 1] = (yb + Dh * bfhi(xv[e])) * silu_f(bfhi(zc[e]));
                    ss += val[2 * e] * val[2 * e] + val[2 * e + 1] * val[2 * e + 1]; }
                ss += shx<1>(ss, lane); ss += shx<2>(ss, lane); ss += shx<4>(ss, lane);
                if (seg == 0) ssq[(size_t)(m0 + row8) * 32 + h] = ss;
                v4u o; o.x = pk2(val[0], val[1]); o.y = pk2(val[2], val[3]); o.z = pk2(val[4], val[5]); o.w = pk2(val[6], val[7]);
                *(v4u*)(obuf + (size_t)(m0 + row8) * 2048 + h * 64 + seg * 8) = o;
            }
            BAR_LDS();
            SS_FILL();
        }
        float* ho = a.out + O_SHP + ((size_t)(j * 8 + b) * 32 + h) * 8192;
#pragma unroll
        for (int q = 0; q < 4; ++q) { const int stile = 4 * sg + q; *(f32x4*)(ho + (16 * ptile + fr) * 128 + stile * 16 + fq * 4) = Hs[q]; }
        BAR_LDS();
    }
#undef SS_LOAD
#undef SS_FILL
    {
        for (int u = su; u < NSEQ_S * 32; u += G) {
            const int b = u >> 5, h = u & 31; const int m0 = TP + 4 * b;
            const float Ah = -__expf(Alog[h]); const float Dh = Dsk[h];
            f32x4 Hr[4]; float dtc[4];
#pragma unroll
            for (int i = 0; i < 4; ++i) Hr[i] = Hn[i];
#pragma unroll
            for (int k = 0; k < 4; ++k) dtc[k] = sdt[k];
            const float zz = bf2f(sz);
#pragma unroll
            for (int k = 0; k < 3; ++k) { const int e = tid + 512 * k; if (e < 1280) { const int tok = e / 320, rem = e - tok * 320; const float v = bf2f(sgv[k]);
                if (rem < 64) xsS[tok * 64 + rem] = v; else if (rem < 192) BS[tok * 128 + rem - 64] = v; else CS[tok * 128 + rem - 192] = v; } }
            BAR_LDS();
            SSS_PREF(u + G < NSEQ_S * 32 ? u + G : u);
#pragma unroll
            for (int tok = 0; tok < 4; ++tok) {
                const float dt = dtc[tok]; const float dA = __expf(dt * Ah);
                const float dx = dt * xsS[tok * 64 + pg]; float y = 0.f;
#pragma unroll
                for (int i = 0; i < 4; ++i) { const f32x4 B4 = *(const LAS f32x4*)(BS + tok * 128 + 16 * sq + 4 * i), C4 = *(const LAS f32x4*)(CS + tok * 128 + 16 * sq + 4 * i);
                    Hr[i] = dA * Hr[i] + dx * B4; y += (Hr[i].x * C4.x + Hr[i].y * C4.y) + (Hr[i].z * C4.z + Hr[i].w * C4.w); }
                y += shx<1>(y, lane); y += shx<2>(y, lane); y += shx<4>(y, lane);
                if (sq == 0) yS[tok * 64 + pg] = y;
            }
            BAR_LDS();
            if (tid < 256) { const int tok = wave, p = lane;
                const float val = (yS[tok * 64 + p] + Dh * xsS[tok * 64 + p]) * silu_f(zz);
                const float ss = wave_sum(lane, val * val); if (lane == 0) ssq[(size_t)(m0 + tok) * 32 + h] = ss;
                obuf[(size_t)(m0 + tok) * 2048 + h * 64 + p] = f2bf(val); }
            float* ho = a.out + O_SHS + ((size_t)j * NSEQ_S * 32 + u) * 8192;
#pragma unroll
            for (int i = 0; i < 4; ++i) *(f32x4*)(ho + pg * 128 + 16 * sq + 4 * i) = Hr[i];
            BAR_LDS();
        }
#undef SSS_PREF
    }
}

constexpr int NSUB = 11, N_PHASES = 1 + 4 * NSUB;
#ifndef REP_SUBMASK
#define REP_LMASK 15
#define REP_SUBMASK 0
#endif
__host__ __device__ __forceinline__ bool phase_is_noop(int ph) { if (ph == 0) return false; const int L = (ph - 1) / NSUB, sub = (ph - 1) % NSUB; (void)L; return sub == 2 || sub == 6 || sub == 10; }

__global__ void __launch_bounds__(512, 2) fwd_kernel(Args a) {
    extern __shared__ __attribute__((aligned(16))) unsigned char lds_raw[];
    LAS unsigned char* lds = (LAS unsigned char*)lds_raw;
    cg::grid_group grid = cg::this_grid();
    if (a.ph_lo < 0) grid.sync();
    volatile LAS unsigned* bst = (volatile LAS unsigned*)(lds + LDS_BYTES - 16);
    if (threadIdx.x == 0) { bst[0] = 0u; bst[1] = 0u; }
    __syncthreads();
    const XcdBarrier gbar = xcd_barrier_post((unsigned*)(a.ws + WS_BAR), bst);
    for (int ph = a.ph_lo; ph < a.ph_hi; ++ph) {
        if (phase_is_noop(ph)) continue;
        int reps = 1;
        if (ph == 0) { if (REP_SUBMASK & 2048) reps = 2; } else if (((REP_SUBMASK >> ((ph - 1) % NSUB)) & 1) && ((REP_LMASK >> ((ph - 1) / NSUB)) & 1)) reps = 2;
        for (int rep = 0; rep < reps; ++rep) {
        int tid = threadIdx.x; asm volatile("" : "+v"(tid));
        int G = gridDim.x, bid = blockIdx.x; asm volatile("" : "+s"(G), "+s"(bid));
        const int lane = tid & 63, wave = __builtin_amdgcn_readfirstlane(tid >> 6);
        unsigned char* ws = a.ws; asm volatile("" : "+s"(ws));
        int cv_lo = 0, cv_hi = 0, cw_id = 0, cw_n = 1;
        if (ph == 0) { phase_prologue(a, lds, wave, lane, bid, G); cv_hi = CV_N0; cw_id = bid * 8 + wave; cw_n = G * 8; }
        else {
            const int L = (ph - 1) / NSUB, sub = (ph - 1) % NSUB, j = L >> 1; const bool isG = (L & 1) == 0;
            bool do_gemm = false, do_res = false;
            const bf16* gA = nullptr; const bf16* gB = nullptr; bf16* gO = nullptr; int gM = 0, gN = 0, gK = 0, gLD = 0, gC = bid;
            const bf16* r_g2 = nullptr;
            int r_lo = 0, r_hi = 0, r_gw = 0, r_ngw = 1; bool r_ffn = false;
            constexpr int NSB = 32;
            bf16* const gpart1 = (bf16*)(ws + WS_GOUT + 40 * MiB);
            bool g_wt = false; int r_np = 0;
            if (sub == 0) { do_gemm = true; gA = (const bf16*)(ws + WS_HN); gM = T; gK = DM; gLD = DM; gO = (bf16*)(ws + WS_PROJ);
                if (isG) { gN = GINP; gB = (const bf16*)(ws + WS_WGIN) + (size_t)j * GINP * DM; } else { gN = SINP; gB = (const bf16*)(ws + WS_WSIN) + (size_t)j * SINP * DM; } }
            else if (sub == 4 || sub == 5 || sub == 8 || sub == 9) {
                const bool dn = sub >= 8; const bool second = (sub == 5 || sub == 9);
                if (!second || bid < NSB) {
                    do_gemm = true; gN = DM;
                    if (!dn) { gA = (const bf16*)(ws + WS_OBUF); gK = isG ? 1024 : 2048; gB = isG ? (const bf16*)(ws + WS_WGOUT) + (size_t)j * DM * DM : (const bf16*)(ws + WS_WSOUT) + (size_t)j * DM * 2048; }
                    else { gA = (const bf16*)(ws + WS_ACT); gK = DFF; gB = (const bf16*)(ws + WS_WDN) + (size_t)L * DM * DFF; }
                    gO = (bf16*)(ws + WS_GOUT); gM = TP;
                    gLD = gK;
                    if (second) { gA += (size_t)TP * gK; gO += (size_t)TP * DM; gM = T - TP;
                        const int ks = bid >> 3, n128 = gK >> 7, k0 = ((ks * n128) >> 2) << 7, k1 = (((ks + 1) * n128) >> 2) << 7;
                        gC = bid & 7; gK = k1 - k0; gA += k0; gB += k0; if (ks) gO = gpart1 + (size_t)(ks - 1) * (T - TP) * DM; g_wt = true; }
                }
            }
            if (do_gemm) {
                pg8::Gemm g{gA, gB, gM, gN, gK, gLD};
                pg8::StaticOrder S; S.init(gM, gN, G, gC);
                pg8::EpiBf16 E{gO, gN, g_wt};
                pg8::gemm_phase<pg8::EpiBf16, pg8::StaticOrder, true, true>(lds, g, S, E);
            }
            if ((sub == 5 || sub == 9) && bid < NSB) {
                asm volatile("s_waitcnt vmcnt(0)" ::: "memory"); __syncthreads();
                if (tid == 0) { unsigned* cnt = (unsigned*)(ws + WS_BAR + 32768) + (L * 2 + (sub == 9 ? 1 : 0)) * 64;
                    __hip_atomic_fetch_add(cnt, 1u, RLX_AGENT_);
                    unsigned spins = 0; while (__hip_atomic_load(cnt, RLX_AGENT_) < (unsigned)NSB && spins < (1u << 22)) { __builtin_amdgcn_s_sleep(2); ++spins; }
                    __builtin_amdgcn_fence(__ATOMIC_ACQUIRE, "agent"); asm volatile("s_waitcnt vmcnt(0)" ::: "memory"); }
                __syncthreads();
            }
            if (sub == 5 || sub == 9) {
                do_res = true; r_ffn = sub == 9;
                if (bid >= NSB) { r_lo = 0; r_hi = TP; r_gw = (bid - NSB) * 8 + wave; r_ngw = (G - NSB) * 8; }
                else { r_lo = TP; r_hi = T; r_gw = bid * 8 + wave; r_ngw = NSB * 8; r_g2 = gpart1 - (size_t)TP * DM; r_np = 3; }
            }
            if (do_res) phase_res(a, L, r_ffn, r_lo, r_hi, r_gw, r_ngw, lane, r_g2, r_np);
            if (sub == 1) { if (isG) phase_conv<true>(a, j, wave, lane, bid, G); else phase_conv<false>(a, j, wave, lane, bid, G); }
            else if (sub == 3) { if (isG) { if (bid >= 64) phase_gp(a, j, lds, tid, wave, lane, bid, G); phase_gs(a, j, lds, tid, wave, lane, bid, G); } else phase_ss(a, j, lds, tid, wave, lane, bid, G); }
            else if (sub == 7) {
                pg8::Gemm g{(const bf16*)(ws + WS_HN), (const bf16*)(ws + WS_WGU) + (size_t)L * 2 * DFF * DM, T, 2 * DFF, DM, DM};
                pg8::StaticOrder S; S.init(T, 2 * DFF, G, bid);
                pg8::EpiSwiGLU E{(bf16*)(ws + WS_ACT), DFF};
                pg8::gemm_phase<pg8::EpiSwiGLU, pg8::StaticOrder, true, true>(lds, g, S, E);
            }
        }
        if (ph > 0) { const int sub_ = (ph - 1) % NSUB, L_ = (ph - 1) / NSUB;
            if (sub_ == 0 || sub_ == 7) {
                const int nN = sub_ == 7 ? (2 * DFF) / 256 : ((L_ & 1) ? SINP / 256 : GINP / 256); const int nwg = (T / 256) * nN, rounds = (nwg + G - 1) / G, c0 = nwg - (rounds - 1) * G, w = 2 * L_ + (sub_ == 7 ? 1 : 0);
                if (bid >= c0 && c0 < G) { cv_lo = CV_N0 + CV_WB(w); cv_hi = CV_N0 + CV_WB(w + 1); cw_id = (bid - c0) * 8 + wave; cw_n = (G - c0) * 8; } } }
        if (cv_hi > cv_lo) phase_convert(a, lds, cv_lo, cv_hi, cw_id, cw_n, wave, lane);
        }
        if (ph + 1 < a.ph_hi) { xcd_barrier(gbar); if (REP_BARRIER) xcd_barrier(gbar); }
    }
}

#ifndef MK_MULTI
#define MK_MULTI 0
#endif
extern "C" void kernel_launch(void* const* d_in, const int* in_sizes, int n_in, void* d_out, int out_size, void* d_ws, size_t ws_size, hipStream_t stream) {
    static int grid = 0;
    if (grid == 0) {
        if (n_in != 27 || (size_t)out_size != O_END || ws_size < WS_END) { fprintf(stderr, "kernel_launch: unexpected shapes n_in %d out %d ws %zu\n", n_in, out_size, ws_size); grid = -1; return; }
        int dev = 0, cus = 0, per_cu = 0;
        hipGetDevice(&dev); hipDeviceGetAttribute(&cus, hipDeviceAttributeMultiprocessorCount, dev);
        if (hipFuncSetAttribute((const void*)fwd_kernel, hipFuncAttributeMaxDynamicSharedMemorySize, LDS_BYTES) != hipSuccess) { fprintf(stderr, "kernel_launch: hipFuncSetAttribute failed\n"); grid = -1; return; }
        if (hipOccupancyMaxActiveBlocksPerMultiprocessor(&per_cu, (const void*)fwd_kernel, 512, LDS_BYTES) != hipSuccess || per_cu < 1) { fprintf(stderr, "kernel_launch: occupancy query gave %d\n", per_cu); per_cu = 1; }
        (void)hipGetLastError();
        grid = cus * (per_cu > 1 ? 1 : per_cu);
        if (grid <= 0) grid = 256;
        if (grid <= 64) { fprintf(stderr, "kernel_launch: this kernel needs more than 64 resident workgroups (got %d)\n", grid); grid = -1; return; }
    }
    if (grid < 0) return;
    if (hipMemsetAsync((char*)d_ws + WS_BAR, 0, 36864, stream) != hipSuccess) { fprintf(stderr, "kernel_launch: memset of barrier words failed\n"); return; }
    Args a{};
    for (int i = 0; i < 27; ++i) a.in[i] = (const float*)d_in[i];
    a.out = (float*)d_out; a.ws = (unsigned char*)d_ws;
#if MK_MULTI
    for (int ph = 0; ph < N_PHASES; ++ph) {
        if (phase_is_noop(ph)) continue;
        a.ph_lo = ph; a.ph_hi = ph + 1;
        void* args[] = {&a};
        hipError_t e = hipLaunchCooperativeKernel((const void*)fwd_kernel, dim3(grid), dim3(512), args, LDS_BYTES, stream);
        if (e != hipSuccess) { fprintf(stderr, "cooperative launch failed (phase %d): %s (grid %d)\n", ph, hipGetErrorString(e), grid); break; }
    }
#else
    a.ph_lo = 0; a.ph_hi = N_PHASES;
    void* args[] = {&a};
    hipError_t e = hipLaunchCooperativeKernel((const void*)fwd_kernel, dim3(grid), dim3(512), args, LDS_BYTES, stream);
    if (e != hipSuccess) fprintf(stderr, "cooperative launch failed: %s (grid %d)\n", hipGetErrorString(e), grid);
#endif
}
```
